# Optimizing an MI355X kernel written in HIP

```python
import math
import jax
import jax.numpy as jnp
from jax import lax
import numpy as np

D_MODEL = 1024
BATCH = 8
SEQ = 4096
DEPTH = 4

GRID_W = 64
CTX_LEN = 256
N_MOD = 9
RMS_EPS = 1e-6
GN_EPS = 1e-6
D_FF = 2816
NA_HEADS = 8
NA_HEAD_DIM = 64
NA_WIDTH = NA_HEADS * NA_HEAD_DIM
WIN_R = 8
WIN_C = 16
HY_WIDTH = D_MODEL - NA_WIDTH
HY_BANDS = 8
HY_EMB = 1 + 2 * HY_BANDS
HY_ORDER = 64
HY_TARGET = 1e-2
HY_FAST_PCT = 0.3
HY_SLOW_PCT = 1.5
EVEN_IN = 3 * NA_WIDTH + 3 * HY_WIDTH
EVEN_CAT = NA_WIDTH + HY_WIDTH
RET_HEADS = 4
RET_KEY_DIM = D_MODEL // RET_HEADS
RET_VAL_DIM = 2 * RET_KEY_DIM
RET_QK = RET_HEADS * RET_KEY_DIM
RET_V = RET_HEADS * RET_VAL_DIM
RET_IN = 2 * RET_QK + 2 * RET_V
RET_CHUNK = 128
ROPE_BASE = 10000.0

kernel_name = "hybrid_na_hyena_retention_dit"


def rms_norm(x, gain):
    xf = x.astype(jnp.float32)
    y = xf * lax.rsqrt(jnp.mean(xf * xf, axis=-1, keepdims=True) + RMS_EPS)
    return (y * gain).astype(x.dtype)


def modulate(x, gain, shift, scale):
    return rms_norm(x, gain) * (1 + scale) + shift


def swiglu(h, w_in, w_out):
    a, b = jnp.split(h @ w_in, 2, axis=-1)
    return (jax.nn.silu(a) * b) @ w_out


def split_heads(t, n_heads):
    b, l, _ = t.shape
    return t.reshape(b, l, n_heads, -1).transpose(0, 2, 1, 3)


def merge_heads(t):
    b, h, l, d = t.shape
    return t.transpose(0, 2, 1, 3).reshape(b, l, h * d)


def axial_rope_tables(length, head_dim):
    t = jnp.arange(length)
    n_freq = head_dim // 4
    inv = ROPE_BASE ** (-jnp.arange(n_freq, dtype=jnp.float32) / n_freq)
    ang_r = (t // GRID_W).astype(jnp.float32)[:, None] * inv
    ang_c = (t % GRID_W).astype(jnp.float32)[:, None] * inv
    ang = jnp.concatenate([ang_r, ang_c], axis=-1)
    return jnp.cos(ang), jnp.sin(ang)


def apply_axial_rope(x, cos, sin):
    nf = x.shape[-1] // 4
    xr1, xr2, xc1, xc2 = jnp.split(x.astype(jnp.float32), 4, axis=-1)
    cr, cc = cos[:, :nf], cos[:, nf:]
    sr, sc = sin[:, :nf], sin[:, nf:]
    out = jnp.concatenate([xr1 * cr - xr2 * sr, xr1 * sr + xr2 * cr,
                           xc1 * cc - xc2 * sc, xc1 * sc + xc2 * cc], axis=-1)
    return out.astype(x.dtype)


def qk_norm(t, gain):
    tf = t.astype(jnp.float32)
    return (tf * lax.rsqrt(jnp.mean(tf * tf, axis=-1, keepdims=True) + RMS_EPS) * gain).astype(t.dtype)


def dense_attention(q, k, v):
    s = jnp.einsum('bhqd,bhkd->bhqk', q, k).astype(jnp.float32) * (q.shape[-1] ** -0.5)
    p = jax.nn.softmax(s, axis=-1).astype(v.dtype)
    return jnp.einsum('bhqk,bhkd->bhqd', p, v)


def neighbourhood_attention(q, k, v, k_ctx, v_ctx, rpb):
    b, h, length, d = q.shape
    rows = length // GRID_W
    wr = min(WIN_R, rows)
    q = q.reshape(b, h, rows, GRID_W, d)
    k = k.reshape(b, h, rows, GRID_W, d)
    v = v.reshape(b, h, rows, GRID_W, d)
    col = jnp.arange(GRID_W)
    col_start = jnp.clip(col - WIN_C // 2, 0, GRID_W - WIN_C)
    col_idx = col_start[:, None] + jnp.arange(WIN_C)[None, :]
    dc_idx = col_idx - col[:, None] + (WIN_C - 1)
    scale = d ** -0.5
    n_win = wr * WIN_C

    def row_block(r):
        rs = jnp.clip(r - wr // 2, 0, rows - wr)
        dr_idx = rs + jnp.arange(wr) - r + (WIN_R - 1)
        bias = rpb[:, dr_idx[None, :, None], dc_idx[:, None, :]].astype(jnp.float32)
        q_r = lax.dynamic_index_in_dim(q, r, axis=2, keepdims=False)
        k_w = jnp.take(lax.dynamic_slice_in_dim(k, rs, wr, axis=2), col_idx, axis=3)
        v_w = jnp.take(lax.dynamic_slice_in_dim(v, rs, wr, axis=2), col_idx, axis=3)
        s_win = jnp.einsum('bhqd,bhrqjd->bhqrj', q_r, k_w).astype(jnp.float32) * scale + bias
        s_ctx = jnp.einsum('bhqd,bhcd->bhqc', q_r, k_ctx).astype(jnp.float32) * scale
        s = jnp.concatenate([s_win.reshape(b, h, GRID_W, n_win), s_ctx], axis=-1)
        p = jax.nn.softmax(s, axis=-1).astype(v.dtype)
        p_win = p[..., :n_win].reshape(b, h, GRID_W, wr, WIN_C)
        return (jnp.einsum('bhqrj,bhrqjd->bhqd', p_win, v_w)
                + jnp.einsum('bhqc,bhcd->bhqd', p[..., n_win:], v_ctx))

    out = lax.map(row_block, jnp.arange(rows))
    return out.transpose(1, 2, 0, 3, 4).reshape(b, h, length, d)


def short_conv(u, w, b):
    up = jnp.pad(u, ((0, 0), (1, 1), (0, 0)))
    return up[:, :-2] * w[0] + up[:, 1:-1] * w[1] + up[:, 2:] * w[2] + b


def hyena_filter(length, fw1, fb1, fw2, fb2, fw3, fb3, fw4, freq):
    t = jnp.linspace(0.0, 1.0, length, dtype=jnp.float32)[:, None]
    w = 2.0 * math.pi * jnp.arange(length, dtype=jnp.float32)[:, None] / length
    bands = jnp.linspace(1e-4, HY_BANDS - 1, HY_BANDS, dtype=jnp.float32)
    emb = jnp.concatenate([t, jnp.cos(bands * w), -jnp.sin(bands * w)], axis=-1)
    h = jnp.sin(freq * (emb @ fw1 + fb1))
    h = jnp.sin(freq * (h @ fw2 + fb2))
    h = jnp.sin(freq * (h @ fw3 + fb3))
    h = (h @ fw4).astype(jnp.float32)
    max_decay = math.log(HY_TARGET) / HY_FAST_PCT
    min_decay = math.log(HY_TARGET) / HY_SLOW_PCT
    deltas = jnp.linspace(min_decay, max_decay, HY_WIDTH, dtype=jnp.float32)
    window = jnp.exp(-t * jnp.abs(deltas))
    h_fwd = h[:, :HY_WIDTH] * window
    h_bwd = h[:, HY_WIDTH:] * window
    return jnp.concatenate([h_fwd[:1] + h_bwd[:1], h_fwd[1:],
                            jnp.zeros((1, HY_WIDTH), jnp.float32), h_bwd[1:][::-1]], axis=0)


def long_conv(u, filt):
    length = u.shape[1]
    uf = jnp.fft.rfft(u.astype(jnp.float32), n=2 * length, axis=1)
    kf = jnp.fft.rfft(filt, n=2 * length, axis=0)
    return jnp.fft.irfft(uf * kf[None], n=2 * length, axis=1)[:, :length]


def hyena_operator(u, conv_w, conv_b, filter_params, d_bias):
    uc = short_conv(u, conv_w, conv_b)
    x0, x1, v = jnp.split(uc, 3, axis=-1)
    z = v * x1
    filt = hyena_filter(u.shape[1], *filter_params)
    y = long_conv(z, filt).astype(z.dtype) + z * d_bias
    return y * x0


def na_hyena_mixer(h_lat, h_ctx, w_in, w_out, q_gain, k_gain, rpb, conv_w, conv_b,
                   filter_params, d_bias, ctx_out):
    p_lat = h_lat @ w_in
    p_ctx = h_ctx @ w_in
    qa_l, ka_l, va_l = [split_heads(t, NA_HEADS) for t in jnp.split(p_lat[..., :3 * NA_WIDTH], 3, axis=-1)]
    qa_c, ka_c, va_c = [split_heads(t, NA_HEADS) for t in jnp.split(p_ctx[..., :3 * NA_WIDTH], 3, axis=-1)]
    k_c = qk_norm(ka_c, k_gain)
    a_lat = merge_heads(neighbourhood_attention(qk_norm(qa_l, q_gain), qk_norm(ka_l, k_gain), va_l,
                                                k_c, va_c, rpb))
    b_lat = hyena_operator(p_lat[..., 3 * NA_WIDTH:], conv_w, conv_b, filter_params, d_bias)
    o_lat = jnp.concatenate([a_lat, b_lat], axis=-1) @ w_out
    if not ctx_out:
        return o_lat, None
    a_ctx = merge_heads(dense_attention(qk_norm(qa_c, q_gain), k_c, va_c))
    b_ctx = hyena_operator(p_ctx[..., 3 * NA_WIDTH:], conv_w, conv_b, filter_params, d_bias)
    o_ctx = jnp.concatenate([a_ctx, b_ctx], axis=-1) @ w_out
    return o_lat, o_ctx


def retention_scan(q, k, v, log_gamma, state0):
    b, h, length, dk = q.shape
    dv = v.shape[-1]
    n = length // RET_CHUNK

    def chunks(a):
        return a.astype(jnp.float32).reshape(b, h, n, RET_CHUNK, a.shape[-1]).transpose(2, 0, 1, 3, 4)

    j = jnp.arange(RET_CHUNK, dtype=jnp.float32)
    diff = j[:, None] - j[None, :]
    lg = log_gamma.astype(jnp.float32)
    dmask = jnp.where(diff[None] >= 0, jnp.exp(lg[:, None, None] * jnp.maximum(diff, 0.0)[None]), 0.0)
    xi = jnp.exp(lg[:, None] * (j + 1.0))
    zeta = jnp.exp(lg[:, None] * (RET_CHUNK - 1.0 - j))
    g_chunk = jnp.exp(lg * RET_CHUNK)

    def step(state, inp):
        qc, kc, vc = inp
        inner = jnp.einsum('bhid,bhjd->bhij', qc, kc) * dmask
        o = (jnp.einsum('bhij,bhje->bhie', inner, vc)
             + jnp.einsum('bhid,bhde->bhie', qc, state) * xi[..., None])
        state = state * g_chunk[:, None, None] + jnp.einsum('bhjd,bhje->bhde', kc * zeta[..., None], vc)
        return state, o

    state, o = lax.scan(step, state0, (chunks(q), chunks(k), chunks(v)))
    return o.transpose(1, 2, 0, 3, 4).reshape(b, h, length, dv), state


def retention_mixer(h_lat, h_ctx, w_in, w_out, logit_f, logit_b, rope_cos, rope_sin, ctx_out):
    def project(hh):
        q, k, v, g = jnp.split(hh @ w_in, [RET_QK, 2 * RET_QK, 2 * RET_QK + RET_V], axis=-1)
        return (split_heads(q, RET_HEADS), split_heads(k, RET_HEADS) * (RET_KEY_DIM ** -0.5),
                split_heads(v, RET_HEADS), g)

    def output(y, g, dtype):
        mu = jnp.mean(y, axis=-1, keepdims=True)
        var = jnp.mean(jnp.square(y - mu), axis=-1, keepdims=True)
        y = merge_heads((y - mu) * lax.rsqrt(var + GN_EPS)).astype(dtype)
        return (jax.nn.silu(g) * y) @ w_out

    q_l, k_l, v_l, g_l = project(h_lat)
    q_l = apply_axial_rope(q_l, rope_cos, rope_sin)
    k_l = apply_axial_rope(k_l, rope_cos, rope_sin)
    q_c, k_c, v_c, g_c = project(h_ctx)
    lg_f = jax.nn.log_sigmoid(logit_f.astype(jnp.float32))
    lg_b = jax.nn.log_sigmoid(logit_b.astype(jnp.float32))
    zero = jnp.zeros((h_lat.shape[0], RET_HEADS, RET_KEY_DIM, RET_VAL_DIM), jnp.float32)
    flip = lambda a: jnp.flip(a, axis=2)
    o_cf, s_f = retention_scan(q_c, k_c, v_c, lg_f, zero)
    o_cb, s_b = retention_scan(flip(q_c), flip(k_c), flip(v_c), lg_b, zero)
    o_lf, _ = retention_scan(q_l, k_l, v_l, lg_f, s_f)
    o_lb, _ = retention_scan(flip(q_l), flip(k_l), flip(v_l), lg_b, s_b)
    o_lat = output(o_lf + flip(o_lb), g_l, h_lat.dtype)
    if not ctx_out:
        return o_lat, None
    o_ctx = output(o_cf + flip(o_cb), g_c, h_ctx.dtype)
    return o_lat, o_ctx


def setup_inputs(seed: int = 0) -> dict:
    key = jax.random.key(seed)
    ks = iter(jax.random.split(key, 40))

    def nrm(shape, scale):
        return scale * jax.random.normal(next(ks), shape, jnp.float32)

    d = D_MODEL
    n_even = (DEPTH + 1) // 2
    n_odd = DEPTH // 2
    gamma = 1.0 - 2.0 ** (-5.0 - np.arange(RET_HEADS))
    logit0 = jnp.asarray(np.log(gamma / (1.0 - gamma)), jnp.float32)
    return {
        "x": nrm((BATCH, SEQ, d), 1.0),
        "c": nrm((BATCH, d), 1.0),
        "ctx": nrm((BATCH, CTX_LEN, d), 1.0),
        "c_ctx": nrm((d,), 1.0),
        "w_mod": nrm((DEPTH, d, N_MOD * d), 0.5 * d ** -0.5),
        "b_mod": nrm((DEPTH, N_MOD * d), 0.02),
        "norm_gain": 1.0 + nrm((DEPTH, 3, d), 0.05),
        "ffn_a_in": nrm((DEPTH, d, 2 * D_FF), d ** -0.5),
        "ffn_a_out": nrm((DEPTH, D_FF, d), D_FF ** -0.5),
        "ffn_b_in": nrm((DEPTH, d, 2 * D_FF), d ** -0.5),
        "ffn_b_out": nrm((DEPTH, D_FF, d), D_FF ** -0.5),
        "even_in": nrm((n_even, d, EVEN_IN), d ** -0.5),
        "even_out": nrm((n_even, EVEN_CAT, d), EVEN_CAT ** -0.5),
        "na_q_gain": 1.0 + nrm((n_even, NA_HEAD_DIM), 0.05),
        "na_k_gain": 1.0 + nrm((n_even, NA_HEAD_DIM), 0.05),
        "na_rpb": nrm((n_even, NA_HEADS, 2 * WIN_R - 1, 2 * WIN_C - 1), 0.1),
        "hy_conv_w": nrm((n_even, 3, 3 * HY_WIDTH), 3 ** -0.5),
        "hy_conv_b": nrm((n_even, 3 * HY_WIDTH), 0.02),
        "hy_fw1": nrm((n_even, HY_EMB, HY_ORDER), HY_EMB ** -0.5),
        "hy_fb1": nrm((n_even, HY_ORDER), 0.1),
        "hy_fw2": nrm((n_even, HY_ORDER, HY_ORDER), HY_ORDER ** -0.5),
        "hy_fb2": nrm((n_even, HY_ORDER), 0.1),
        "hy_fw3": nrm((n_even, HY_ORDER, HY_ORDER), HY_ORDER ** -0.5),
        "hy_fb3": nrm((n_even, HY_ORDER), 0.1),
        "hy_fw4": nrm((n_even, HY_ORDER, 2 * HY_WIDTH), 0.05 * HY_ORDER ** -0.5),
        "hy_freq": 1.0 + nrm((n_even, HY_ORDER), 0.1),
        "hy_bias": nrm((n_even, HY_WIDTH), 0.5),
        "ret_in": nrm((n_odd, d, RET_IN), d ** -0.5),
        "ret_out": nrm((n_odd, RET_V, d), RET_V ** -0.5),
        "ret_logit_f": logit0 + nrm((n_odd, RET_HEADS), 0.1),
        "ret_logit_b": logit0 + nrm((n_odd, RET_HEADS), 0.1),
    }


def reference(x, c, ctx, c_ctx, w_mod, b_mod, norm_gain, ffn_a_in, ffn_a_out, ffn_b_in, ffn_b_out,
              even_in, even_out, na_q_gain, na_k_gain, na_rpb, hy_conv_w, hy_conv_b,
              hy_fw1, hy_fb1, hy_fw2, hy_fb2, hy_fw3, hy_fb3, hy_fw4, hy_freq, hy_bias,
              ret_in, ret_out, ret_logit_f, ret_logit_b):
    b = x.shape[0]
    rope_cos, rope_sin = axial_rope_tables(x.shape[1], RET_KEY_DIM)
    x_lat, x_ctx = x, ctx
    for i in range(DEPTH):
        last = i == DEPTH - 1
        mod_l = (jax.nn.silu(c) @ w_mod[i] + b_mod[i]).reshape(b, N_MOD, 1, D_MODEL)
        mod_c = (jax.nn.silu(c_ctx) @ w_mod[i] + b_mod[i]).reshape(N_MOD, 1, D_MODEL)
        x_lat = x_lat + 0.5 * mod_l[:, 2] * swiglu(modulate(x_lat, norm_gain[i, 0], mod_l[:, 0], mod_l[:, 1]),
                                                 ffn_a_in[i], ffn_a_out[i])
        x_ctx = x_ctx + 0.5 * mod_c[2] * swiglu(modulate(x_ctx, norm_gain[i, 0], mod_c[0], mod_c[1]),
                                              ffn_a_in[i], ffn_a_out[i])
        h_l = modulate(x_lat, norm_gain[i, 1], mod_l[:, 3], mod_l[:, 4])
        h_c = modulate(x_ctx, norm_gain[i, 1], mod_c[3], mod_c[4])
        if i % 2 == 0:
            e = i // 2
            filter_params = (hy_fw1[e], hy_fb1[e], hy_fw2[e], hy_fb2[e], hy_fw3[e], hy_fb3[e], hy_fw4[e], hy_freq[e])
            o_l, o_c = na_hyena_mixer(h_l, h_c, even_in[e], even_out[e], na_q_gain[e], na_k_gain[e], na_rpb[e],
                                      hy_conv_w[e], hy_conv_b[e], filter_params, hy_bias[e], not last)
        else:
            o = i // 2
            o_l, o_c = retention_mixer(h_l, h_c, ret_in[o], ret_out[o], ret_logit_f[o], ret_logit_b[o],
                                       rope_cos, rope_sin, not last)
        x_lat = x_lat + mod_l[:, 5] * o_l
        x_lat = x_lat + 0.5 * mod_l[:, 8] * swiglu(modulate(x_lat, norm_gain[i, 2], mod_l[:, 6], mod_l[:, 7]),
                                                 ffn_b_in[i], ffn_b_out[i])
        if not last:
            x_ctx = x_ctx + mod_c[5] * o_c
            x_ctx = x_ctx + 0.5 * mod_c[8] * swiglu(modulate(x_ctx, norm_gain[i, 2], mod_c[6], mod_c[7]),
                                                  ffn_b_in[i], ffn_b_out[i])
    return x_lat
```

```cpp
#include <hip/hip_runtime.h>
#include <hip/hip_cooperative_groups.h>
#include <cstdio>
#include <cstdint>
namespace cg = cooperative_groups;
namespace pg8 {
#define PG8_LAS __attribute__((address_space(3)))
typedef unsigned short bf16_t;
typedef short bf16x8 __attribute__((ext_vector_type(8)));
typedef float f32x4 __attribute__((ext_vector_type(4)));
typedef unsigned u32x4 __attribute__((ext_vector_type(4)));
constexpr int BM = 256, BK = 64, HALF = 128, HTB = HALF * BK * 2  , STAGE_BYTES = 8 * HTB, NXCD = 8, WGM = 8;

__host__ __device__ __forceinline__ int lds_byte(int r, int c) { const int st = (r >> 4) * 2 + (c >> 5), rr = r & 15, cc = c & 31, ob = rr * 64 + cc * 2; return st * 1024 + (ob ^ (((ob >> 9) & 1) << 5)); }
__host__ __device__ __forceinline__ void stage_rc(int b, int& R, int& C) { const int st = b / 1024, sb = b % 1024, swz = sb ^ (((sb >> 9) & 1) << 5); R = (st >> 1) * 16 + swz / 64; C = (st & 1) * 32 + (swz % 64) / 2; }
__host__ __device__ __forceinline__ int perm32(int rho) { const int n = rho >> 4, i = rho & 15; return 8 * (i >> 2) + 4 * n + (i & 3); }

struct Unit { int pm, pn, k0, nt, split, which; };
struct Gemm { const bf16_t* A; const bf16_t* Bt; int M, N, K; const bf16_t* A2; const bf16_t* Bt2; };

struct StaticOrder {
    int nM, nN, nwg, G, c, ntK, tailM, nM2, nN2, nwg2, loff, imax;
    __host__ __device__ void init(int M, int N, int G_, int c_, int K = 1024, int tailRows = 0, int M2 = 0, int N2 = 0, int loff_ = 0, int imax_ = 1 << 30) { loff = loff_; imax = imax_; nM = M / BM; nN = N / BM; nwg = nM * nN; G = G_; c = c_; ntK = K / BK; tailM = tailRows / BM; nM2 = M2 / BM; nN2 = N2 / BM; nwg2 = nM2 * nN2; }
    __host__ __device__ static void tile_of(int wgid, int nM_, int nN_, int nwg_, int& pm, int& pn) {
        { const int q = nwg_ / NXCD, r = nwg_ % NXCD, xcd = wgid % NXCD, off = wgid / NXCD; wgid = (xcd < r ? xcd * (q + 1) : r * (q + 1) + (xcd - r) * q) + off; }
        const int nig = WGM * nN_, gid = wgid / nig, fm = gid * WGM, gsz = (nM_ - fm) < WGM ? (nM_ - fm) : WGM;
        pm = fm + ((wgid % nig) % gsz); pn = (wgid % nig) / gsz;
    }
    __host__ __device__ bool next(int i, Unit& u) const {
        if (i >= imax) return false;
        const long L = (long)i * G + c + loff;
        u.which = 0;
        if (L >= nwg) {
            if (nwg2) { const long l2 = L - nwg; if (l2 >= nwg2) return false; tile_of((int)l2, nM2, nN2, nwg2, u.pm, u.pn); u.k0 = 0; u.nt = ntK; u.split = 0; u.which = 1; return true; }
            const long idx = L - nwg; if (idx >= (long)tailM * nN * 4) return false;
            const int tile = (int)(idx >> 2), sp = (int)(idx & 3); u.pm = nM + tile / nN; u.pn = tile % nN;
            const int h = ntK >> 1, hb = h >> 2, hr = h & 3;
            const int p0 = sp * hb + (sp < hr ? sp : hr), pc = hb + (sp < hr ? 1 : 0);
            u.k0 = 2 * p0; u.nt = 2 * pc; u.split = sp + 1; return true;
        }
        tile_of((int)L, nM, nN, nwg, u.pm, u.pn); u.k0 = 0; u.nt = ntK; u.split = 0; return true;
    }
    __device__ __forceinline__ void a_ready(const Unit&) const {}
    __device__ __forceinline__ void done(const Unit&) const {}
};

struct FusedOrder {
    int c, hh, ntK, tail;
    __host__ __device__ void init(int, int, int, int c_, int K, int tailRows, int hh_) { c = c_; hh = hh_; ntK = K / BK; tail = tailRows > 0 ? 1 : 0; }
    __host__ __device__ bool next(int i, Unit& u) const {
        const bool ht = tail && c < 128;
        if (ht && i == 0) { const int tile = c >> 2, sp = c & 3; u.pm = 128 + (tile >> 2); u.pn = tile & 3; const int h = ntK >> 1, hb = h >> 2, hr = h & 3; const int p0 = sp * hb + (sp < hr ? sp : hr), pc = hb + (sp < hr ? 1 : 0);
            u.k0 = 2 * p0; u.nt = 2 * pc; u.split = sp + 1; u.which = 0; return true; }
        if (i == (ht ? 1 : 0)) { StaticOrder::tile_of(c + hh * 256, 128, 4, 512, u.pm, u.pn); u.k0 = 0; u.nt = ntK; u.split = 0; u.which = 0; return true; }
        return false;
    }
    __device__ __forceinline__ void a_ready(const Unit&) const {}
    __device__ __forceinline__ void done(const Unit&) const {}
};
__device__ __forceinline__ unsigned cvt_pk_bf16(float lo, float hi) { unsigned r; asm volatile("v_cvt_pk_bf16_f32 %0, %1, %2" : "=v"(r) : "v"(lo), "v"(hi)); return r; }
typedef float f32x2 __attribute__((ext_vector_type(2)));
template <class Epi, class Sched, bool ALIGN_EPI = false, bool SP2 = false>
__device__ __forceinline__ void gemm_phase(PG8_LAS unsigned char* lds, const Gemm g, const Sched& S, const Epi& E) {
    int tid_l = threadIdx.x; asm volatile("" : "+v"(tid_l)); const int tid = tid_l, wid = __builtin_amdgcn_readfirstlane(tid >> 6), lane = tid & 63, wr = wid >> 2, wc = wid & 3, fr = lane & 15, fq = lane >> 4;
    const int K = g.K;
    unsigned voffA[2], voffB[2];
#pragma unroll
    for (int i = 0; i < 2; ++i) { int R, C; stage_rc(tid * 16 + i * 8192, R, C); const int Rb = Epi::PERM ? ((R & ~31) + perm32(R & 31)) : R;
        voffA[i] = (unsigned)(R * K + C) * 2u; voffB[i] = (unsigned)(Rb * K + C) * 2u; }
    const size_t kstep = (size_t)(BK * 2);
    const size_t hstep = (size_t)HALF * K * 2;
    const size_t tstep = 2 * hstep;
    const unsigned ldsw = (unsigned)wid * 1024u;
    const int aoff = lds_byte(wr * 64 + fr, fq * 8), boff = lds_byte(wc * 32 + fr, fq * 8);
#define PG8_SA(b, h) (((b) * 2 + (h)) * HTB)
#define PG8_SB(b, h) ((4 + (b) * 2 + (h)) * HTB)
#define PG8_STAGE(bufoff, gbase, voff) do { _Pragma("unroll") for (int _i = 0; _i < 2; ++_i) \
        __builtin_amdgcn_global_load_lds((const unsigned*)((const char*)(gbase) + (voff)[_i]), (PG8_LAS unsigned*)(lds + (bufoff) + ldsw + _i * 8192), 16, 0, 0); } while (0)
#define PG8_LDA(dst, b, h) do { _Pragma("unroll") for (int m = 0; m < 4; ++m) _Pragma("unroll") for (int k = 0; k < 2; ++k) dst[m][k] = *(const PG8_LAS bf16x8*)(lds + PG8_SA(b, h) + aoff + m * 2048 + k * 1024); } while (0)
#define PG8_LDB(dst, b, h) do { _Pragma("unroll") for (int n = 0; n < 2; ++n) _Pragma("unroll") for (int k = 0; k < 2; ++k) dst[n][k] = *(const PG8_LAS bf16x8*)(lds + PG8_SB(b, h) + boff + n * 2048 + k * 1024); } while (0)
#define PG8_MMA(ai, bj, At, Bt) do { __builtin_amdgcn_s_setprio(1); _Pragma("unroll") for (int m = 0; m < 4; ++m) _Pragma("unroll") for (int n = 0; n < 2; ++n) _Pragma("unroll") for (int k = 0; k < 2; ++k) \
        acc[ai][bj][m][n] = __builtin_amdgcn_mfma_f32_16x16x32_bf16(Bt[n][k], At[m][k], acc[ai][bj][m][n], 0, 0, 0); __builtin_amdgcn_s_setprio(0); } while (0)
#define PG8_WAIT_V(n) asm volatile("s_waitcnt vmcnt(" #n ")" ::: "memory")
#define PG8_WAIT_L(n) asm volatile("s_waitcnt lgkmcnt(" #n ")" ::: "memory")
#define PG8_BAR __builtin_amdgcn_s_barrier()
#define PG8_SCHED __builtin_amdgcn_sched_barrier(0)
    Unit cur, nxt; int ui = 0;
    if (!S.next(0, cur)) return;
    f32x4 acc[2][2][4][2];
#pragma unroll
    for (int a = 0; a < 2; ++a)
#pragma unroll
        for (int b = 0; b < 2; ++b)
#pragma unroll
            for (int m = 0; m < 4; ++m)
#pragma unroll
                for (int n = 0; n < 2; ++n) acc[a][b][m][n] = (f32x4){0.f, 0.f, 0.f, 0.f};
    bf16x8 At[4][2], B0[2][2], B1[2][2];
    const char* cA = (const char*)(cur.which ? g.A2 : g.A) + (size_t)cur.pm * tstep + (size_t)cur.k0 * kstep; const char* cB = (const char*)(cur.which ? g.Bt2 : g.Bt) + (size_t)cur.pn * tstep + (size_t)cur.k0 * kstep;
    S.a_ready(cur);
    if constexpr (SP2) {
        PG8_STAGE(PG8_SB(0, 0), cB, voffB); PG8_STAGE(PG8_SB(0, 1), cB + hstep, voffB); PG8_STAGE(PG8_SA(0, 0), cA, voffA); PG8_STAGE(PG8_SA(0, 1), cA + hstep, voffA);
        if (wr == 1) PG8_BAR;
        PG8_WAIT_V(2); PG8_BAR;
        PG8_STAGE(PG8_SB(1, 0), cB + kstep, voffB); PG8_STAGE(PG8_SA(1, 0), cA + kstep, voffA); PG8_STAGE(PG8_SB(1, 1), cB + hstep + kstep, voffB);
        PG8_WAIT_V(6); PG8_BAR;
    } else {
        PG8_STAGE(PG8_SB(0, 0), cB, voffB); PG8_STAGE(PG8_SA(0, 0), cA, voffA); PG8_STAGE(PG8_SB(0, 1), cB + hstep, voffB); PG8_STAGE(PG8_SA(0, 1), cA + hstep, voffA);
        if (wr == 1) PG8_BAR;
        PG8_WAIT_V(4); PG8_BAR;
        PG8_STAGE(PG8_SB(1, 0), cB + kstep, voffB); PG8_STAGE(PG8_SA(1, 0), cA + kstep, voffA); PG8_STAGE(PG8_SB(1, 1), cB + hstep + kstep, voffB);
        PG8_WAIT_V(6); PG8_BAR;
    }
    for (;;) {
        const bool has_next = S.next(ui + 1, nxt);
        const char* nA = has_next ? (const char*)(nxt.which ? g.A2 : g.A) + (size_t)nxt.pm * tstep + (size_t)nxt.k0 * kstep : cA; const char* nB = has_next ? (const char*)(nxt.which ? g.Bt2 : g.Bt) + (size_t)nxt.pn * tstep + (size_t)nxt.k0 * kstep : cB;
        const int nt = cur.nt;
        for (int t = 0; t < nt; t += 2) {
            const bool last = (t == nt - 2);
            const char* a1 = cA + (size_t)(t + 1) * kstep;
            const char* a2 = last ? nA : cA + (size_t)(t + 2) * kstep; const char* b2 = last ? nB : cB + (size_t)(t + 2) * kstep;
            const char* a3 = a2 + kstep; const char* b3 = b2 + kstep;
            if (last && has_next) S.a_ready(nxt);
            if constexpr (SP2) {
            PG8_LDB(B0, 0, 0); PG8_LDB(B1, 0, 1); PG8_SCHED; PG8_LDA(At, 0, 0); PG8_STAGE(PG8_SA(1, 1), a1 + hstep, voffA);
            PG8_WAIT_V(8); PG8_WAIT_L(0); PG8_BAR; PG8_MMA(0, 0, At, B0); PG8_MMA(0, 1, At, B1); PG8_BAR; PG8_SCHED;
            PG8_LDA(At, 0, 1); PG8_STAGE(PG8_SB(0, 0), b2, voffB); PG8_STAGE(PG8_SB(0, 1), b2 + hstep, voffB); PG8_STAGE(PG8_SA(0, 0), a2, voffA);
            PG8_WAIT_V(8); PG8_WAIT_L(0); PG8_BAR; PG8_MMA(1, 0, At, B0); PG8_MMA(1, 1, At, B1); PG8_BAR; PG8_SCHED;
            PG8_LDB(B0, 1, 0); PG8_LDB(B1, 1, 1); PG8_SCHED; PG8_LDA(At, 1, 0); PG8_STAGE(PG8_SA(0, 1), a2 + hstep, voffA);
            PG8_WAIT_V(8); PG8_WAIT_L(0); PG8_BAR; PG8_MMA(0, 0, At, B0); PG8_MMA(0, 1, At, B1); PG8_BAR; PG8_SCHED;
            PG8_LDA(At, 1, 1); PG8_STAGE(PG8_SB(1, 0), b3, voffB); PG8_STAGE(PG8_SB(1, 1), b3 + hstep, voffB); PG8_STAGE(PG8_SA(1, 0), a3, voffA);
            PG8_WAIT_V(8); PG8_WAIT_L(0); PG8_BAR; PG8_MMA(1, 0, At, B0); PG8_MMA(1, 1, At, B1); PG8_BAR; PG8_SCHED;
            } else {
            PG8_LDB(B0, 0, 0); PG8_SCHED; PG8_LDA(At, 0, 0); PG8_STAGE(PG8_SA(1, 1), a1 + hstep, voffA);
            PG8_WAIT_L(8); PG8_BAR; PG8_WAIT_L(0); PG8_MMA(0, 0, At, B0); PG8_BAR; PG8_SCHED;
            PG8_LDB(B1, 0, 1); PG8_STAGE(PG8_SB(0, 0), b2, voffB);
            PG8_BAR; PG8_WAIT_L(0); PG8_MMA(0, 1, At, B1); PG8_BAR;
            PG8_LDA(At, 0, 1); PG8_STAGE(PG8_SA(0, 0), a2, voffA);
            PG8_BAR; PG8_WAIT_L(0); PG8_MMA(1, 0, At, B0); PG8_BAR; PG8_SCHED;
            PG8_STAGE(PG8_SB(0, 1), b2 + hstep, voffB);
            PG8_WAIT_V(6); PG8_BAR; PG8_MMA(1, 1, At, B1); PG8_BAR;
            PG8_LDB(B0, 1, 0); PG8_SCHED; PG8_LDA(At, 1, 0); PG8_STAGE(PG8_SA(0, 1), a2 + hstep, voffA);
            PG8_WAIT_L(8); PG8_BAR; PG8_WAIT_L(0); PG8_MMA(0, 0, At, B0); PG8_BAR; PG8_SCHED;
            PG8_LDB(B1, 1, 1); PG8_STAGE(PG8_SB(1, 0), b3, voffB);
            PG8_BAR; PG8_WAIT_L(0); PG8_MMA(0, 1, At, B1); PG8_BAR;
            PG8_LDA(At, 1, 1); PG8_STAGE(PG8_SA(1, 0), a3, voffA);
            PG8_BAR; PG8_WAIT_L(0); PG8_MMA(1, 0, At, B0); PG8_BAR; PG8_SCHED;
            PG8_STAGE(PG8_SB(1, 1), b3 + hstep, voffB);
            PG8_WAIT_V(6); PG8_BAR; PG8_MMA(1, 1, At, B1); PG8_BAR;
            }
        }
        if constexpr (ALIGN_EPI) { if (wr == 0) PG8_BAR; }
        if constexpr (!Epi::AFTER_DRAIN) { E(acc, cur, wr, wc, fr, fq); S.done(cur); }
        else { if (has_next) { E(acc, cur, wr, wc, fr, fq); S.done(cur); } }
        if (!has_next) break;
#pragma unroll
        for (int a = 0; a < 2; ++a)
#pragma unroll
            for (int b = 0; b < 2; ++b)
#pragma unroll
                for (int m = 0; m < 4; ++m)
#pragma unroll
                    for (int n = 0; n < 2; ++n) acc[a][b][m][n] = (f32x4){0.f, 0.f, 0.f, 0.f};
        cur = nxt; cA = nA; cB = nB; ++ui;
        if constexpr (ALIGN_EPI) { if (wr == 1) PG8_BAR; }
    }
    PG8_WAIT_V(0);
    if constexpr (!ALIGN_EPI) { if (wr == 0) PG8_BAR; }
    PG8_BAR;
    if constexpr (Epi::AFTER_DRAIN) { E.fused(acc, cur, wr, wc, fr, fq, lds, wid, lane); S.done(cur); }
#undef PG8_SA
#undef PG8_SB
#undef PG8_STAGE
#undef PG8_LDA
#undef PG8_LDB
#undef PG8_MMA
#undef PG8_WAIT_V
#undef PG8_WAIT_L
#undef PG8_BAR
#undef PG8_SCHED
}
}
constexpr int DM = 1024, NBATCH = 8, SEQ = 4096, CTXL = 256, NLAT = NBATCH * SEQ, NCTX = NBATCH * CTXL, NTOK = NLAT + NCTX, DFF = 2816;
constexpr int NMODV = 9 * DM;
constexpr size_t MiB = 1u << 20;
constexpr size_t WS_TAB = 0;
constexpr size_t WS_MOD = 1 * MiB;
constexpr size_t WS_GIL = 3 * MiB;
constexpr size_t WS_GIC = 3 * MiB + 8404992;
constexpr size_t WS_XC = 12 * MiB;
constexpr size_t WS_H = 20 * MiB;
constexpr size_t WS_W = 88 * MiB;
constexpr size_t W_AIN = 0, W_AOUT = 11 * MiB, W_BIN = W_AOUT + 5632 * 1024, W_BOUT = W_BIN + 11 * MiB, W_MIN = 33 * MiB, W_MOUT = 45 * MiB;
constexpr size_t WS_BIG = 137 * MiB;
constexpr size_t BIG_G = 0;
constexpr size_t EV_QK = 0, EV_UT = 68 * MiB, EV_BT = 204 * MiB, EV_CAT = 238 * MiB;
constexpr size_t RT_QK = 0, RT_O = 272 * MiB;
constexpr size_t BIG_XCH = 442 * MiB;
constexpr size_t WS_GAIN = WS_MOD + 1400000;
constexpr size_t WS_PCNT = 131072;
constexpr size_t BIG_STATS = 440 * MiB;
constexpr size_t BIG_PART = 408 * MiB;
constexpr size_t WS_NEED = WS_BIG + 472 * MiB;
constexpr int GIL_P = 2 * SEQ + 16, GIC_P = 2 * CTXL + 16;
constexpr int LDS_BYTES = 147456;

typedef unsigned short bf16;
typedef unsigned short bf16_t;
typedef short bf16x8 __attribute__((ext_vector_type(8)));
typedef float f32x4 __attribute__((ext_vector_type(4)));
typedef unsigned u32x4 __attribute__((ext_vector_type(4)));
typedef unsigned u32x2 __attribute__((ext_vector_type(2)));
#define LAS __attribute__((address_space(3)))

__device__ __forceinline__ unsigned f2bf(float f) { unsigned u = __builtin_bit_cast(unsigned, f); return (u + 0x7fffu + ((u >> 16) & 1u)) >> 16; }
__device__ __forceinline__ unsigned pk2(float lo, float hi) { unsigned r; asm("v_cvt_pk_bf16_f32 %0, %1, %2" : "=v"(r) : "v"(lo), "v"(hi)); return r; }
__device__ __forceinline__ float bflo(unsigned w) { return __builtin_bit_cast(float, w << 16); }
__device__ __forceinline__ float bfhi(unsigned w) { return __builtin_bit_cast(float, w & 0xffff0000u); }
__device__ __forceinline__ float bf2f(unsigned short h) { return __builtin_bit_cast(float, ((unsigned)h) << 16); }
__device__ __forceinline__ float siluf(float a) { return a / (1.f + __expf(-a)); }
__device__ __forceinline__ f32x4 mfma16(bf16x8 a, bf16x8 b, f32x4 c) { return __builtin_amdgcn_mfma_f32_16x16x32_bf16(a, b, c, 0, 0, 0); }

__device__ __forceinline__ int TIDX() { int t = threadIdx.x; asm volatile("" : "+v"(t)); return t; }
__device__ __forceinline__ int BIDX() { int t = blockIdx.x; asm volatile("" : "+s"(t)); return t; }
struct KArgs { const float* in[31]; float* out; unsigned char* ws; int ph_lo, ph_hi; };
__device__ __forceinline__ const float* AIN(const KArgs& a, int i) { int z = 0; asm volatile("" : "+s"(z)); return a.in[i + z]; }
__device__ __forceinline__ unsigned char* WSB(const KArgs& a) { size_t z = 0; asm volatile("" : "+s"(z)); return a.ws + z; }

using pg8::Unit;
struct EpiBf16 {
    static constexpr bool PERM = false, AFTER_DRAIN = false;
    bf16* O; size_t ldc; bf16* O2; size_t ldc2;
    __device__ __forceinline__ void operator()(const f32x4 (&acc)[2][2][4][2], const Unit& u, int wr, int wc, int fr_, int fq_) const {
        int fr = fr_, fq = fq_; asm volatile("" : "+v"(fr), "+v"(fq));
#pragma unroll
        for (int ai = 0; ai < 2; ++ai)
#pragma unroll
            for (int m = 0; m < 4; ++m) { const size_t row = (size_t)u.pm * 256 + ai * 128 + wr * 64 + m * 16 + fr; bf16* Ob = u.which ? O2 : O; const size_t ld = u.which ? ldc2 : ldc;
#pragma unroll
                for (int bj = 0; bj < 2; ++bj)
#pragma unroll
                    for (int n = 0; n < 2; ++n) { const int col = u.pn * 256 + bj * 128 + wc * 32 + 16 * n + 4 * fq; const f32x4 v = acc[ai][bj][m][n];
                        u32x2 w; w.x = pk2(v[0], v[1]); w.y = pk2(v[2], v[3]); *(u32x2*)(Ob + row * ld + col) = w; } }
    }
};
struct EpiSwiGLU {
    static constexpr bool PERM = false, AFTER_DRAIN = false;
    bf16* G;
    __device__ __forceinline__ void operator()(const f32x4 (&acc)[2][2][4][2], const Unit& u, int wr, int wc, int fr_, int fq_) const {
        int fr = fr_, fq = fq_; asm volatile("" : "+v"(fr), "+v"(fq));
        const int hcol = u.pn * 128 + wc * 32 + 8 * fq;
#pragma unroll
        for (int ai = 0; ai < 2; ++ai)
#pragma unroll
            for (int m = 0; m < 4; ++m) { const size_t row = (size_t)u.pm * 256 + ai * 128 + wr * 64 + m * 16 + fr;
                const f32x4 a0 = acc[ai][0][m][0], b0 = acc[ai][0][m][1], a1 = acc[ai][1][m][0], b1 = acc[ai][1][m][1];
                u32x4 w; w.x = pk2(siluf(a0[0]) * b0[0], siluf(a0[1]) * b0[1]); w.y = pk2(siluf(a0[2]) * b0[2], siluf(a0[3]) * b0[3]);
                w.z = pk2(siluf(a1[0]) * b1[0], siluf(a1[1]) * b1[1]); w.w = pk2(siluf(a1[2]) * b1[2], siluf(a1[3]) * b1[3]);
                *(u32x4*)(G + row * DFF + hcol) = w; }
    }
};
struct EpiResid {
    static constexpr bool PERM = false, AFTER_DRAIN = false;
    float* xl; unsigned char* wsb; const float* xin; int moff; float coef;
    __device__ __forceinline__ void operator()(const f32x4 (&acc)[2][2][4][2], const Unit& u, int wr, int wc, int fr_, int fq_) const {
        int fr = fr_, fq = fq_; asm volatile("" : "+v"(fr), "+v"(fq));
        float* xc = (float*)(wsb + WS_XC); const float* modv = (const float*)(wsb + WS_MOD) + moff;
        const int row0 = u.pm * 256; const int bidx = row0 < NLAT ? (row0 >> 12) : 8;
        float* xb = row0 < NLAT ? xl + (size_t)row0 * DM : xc + (size_t)(row0 - NLAT) * DM; const float* xrd = row0 < NLAT ? xin + (size_t)row0 * DM : xb; const float* mv = modv + (size_t)bidx * NMODV;
        if (u.split) {
            float* pb = (float*)((unsigned char*)xc + (WS_BIG + BIG_PART - WS_XC)) + ((size_t)(u.split - 1) * NCTX + (row0 - NLAT)) * DM;
#pragma unroll
            for (int bj = 0; bj < 2; ++bj)
#pragma unroll
                for (int n = 0; n < 2; ++n) { const int col = u.pn * 256 + bj * 128 + wc * 32 + 16 * n + 4 * fq; const f32x4 g = *(const f32x4*)(mv + col) * coef;
#pragma unroll
                    for (int ai = 0; ai < 2; ++ai)
#pragma unroll
                        for (int m = 0; m < 4; ++m) *(f32x4*)(pb + (unsigned)((ai * 128 + wr * 64 + m * 16 + fr) * DM + col)) = g * acc[ai][bj][m][n]; }
            return;
        }
#pragma unroll
        for (int bj = 0; bj < 2; ++bj)
#pragma unroll
            for (int n = 0; n < 2; ++n) { const int col = u.pn * 256 + bj * 128 + wc * 32 + 16 * n + 4 * fq; const f32x4 g = *(const f32x4*)(mv + col) * coef;
#pragma unroll
                for (int ai = 0; ai < 2; ++ai) {
                    f32x4 xv[4];
#pragma unroll
                    for (int m = 0; m < 4; ++m) xv[m] = *(const f32x4*)(xrd + (unsigned)((ai * 128 + wr * 64 + m * 16 + fr) * DM + col));
#pragma unroll
                    for (int m = 0; m < 4; ++m) { const f32x4 xn = xv[m] + g * acc[ai][bj][m][n]; const unsigned ro = (unsigned)((ai * 128 + wr * 64 + m * 16 + fr) * DM + col);
                        *(f32x4*)(xb + ro) = xn; } } }
    }
};
struct EpiResidNorm {
    static constexpr bool PERM = false, AFTER_DRAIN = true;
    float* xl; unsigned char* wsb; const float* xin; int code;
    __device__ __forceinline__ void operator()(const f32x4 (&acc)[2][2][4][2], const Unit& u, int wr, int wc, int fr_, int fq_) const {
        int fr = fr_, fq = fq_; asm volatile("" : "+v"(fr), "+v"(fq));
        size_t zz = 0; asm volatile("" : "+s"(zz)); const int code = this->code + (int)zz; unsigned char* const wsb = this->wsb + zz;
        const int kmod = code & 15, layer = (code >> 9) & 7; const float coef = ((code >> 20) & 1) ? 0.5f : 1.0f;
        const int row0 = u.pm * 256; const float* mv = (const float*)(wsb + WS_MOD) + ((size_t)layer * 9 + 8) * NMODV + kmod * DM;
        float* pb = (float*)(wsb + WS_BIG + BIG_PART) + ((size_t)(u.split - 1) * NCTX + (row0 - NLAT)) * DM;
#pragma unroll
        for (int bj = 0; bj < 2; ++bj)
#pragma unroll
            for (int n = 0; n < 2; ++n) { const int col = u.pn * 256 + bj * 128 + wc * 32 + 16 * n + 4 * fq; const f32x4 g = *(const f32x4*)(mv + col) * coef;
#pragma unroll
                for (int ai = 0; ai < 2; ++ai)
#pragma unroll
                    for (int m = 0; m < 4; ++m) *(f32x4*)(pb + (unsigned)((ai * 128 + wr * 64 + m * 16 + fr) * DM + col)) = g * acc[ai][bj][m][n]; }
    }
    __device__ __forceinline__ void fused(f32x4 (&acc)[2][2][4][2], const Unit& u, int wr, int wc, int fr_, int fq_, LAS unsigned char* lds, int wid, int lane) const {
        int fr = fr_, fq = fq_; asm volatile("" : "+v"(fr), "+v"(fq));
        size_t zz = 0; asm volatile("" : "+s"(zz)); const int code = this->code + (int)zz; unsigned char* const wsb = this->wsb + zz; float* const xl = this->xl + zz; const float* const xin = this->xin + zz;
        const int kmod = code & 15, nsub = (code >> 4) & 3, nlayer = (code >> 6) & 7, layer = (code >> 9) & 7, bank = (code >> 12) & 255; const float coef = ((code >> 20) & 1) ? 0.5f : 1.0f;
        const int row0 = u.pm * 256; const int bidx = row0 >> 12;
        float* xb = xl + (size_t)row0 * DM; const float* xrd = xin + (size_t)row0 * DM;
        const float* MODb = (const float*)(wsb + WS_MOD);
        const float* mv = MODb + ((size_t)layer * 9 + bidx) * NMODV + kmod * DM;
#pragma unroll
        for (int bj = 0; bj < 2; ++bj)
#pragma unroll
            for (int n = 0; n < 2; ++n) { const int col = u.pn * 256 + bj * 128 + wc * 32 + 16 * n + 4 * fq; const f32x4 g = *(const f32x4*)(mv + col) * coef;
#pragma unroll
                for (int ai = 0; ai < 2; ++ai) {
                    f32x4 xv[4];
#pragma unroll
                    for (int m = 0; m < 4; ++m) xv[m] = *(const f32x4*)(xrd + (unsigned)((ai * 128 + wr * 64 + m * 16 + fr) * DM + col));
#pragma unroll
                    for (int m = 0; m < 4; ++m) { const f32x4 xn = xv[m] + g * acc[ai][bj][m][n]; acc[ai][bj][m][n] = xn; *(f32x4*)(xb + (unsigned)((ai * 128 + wr * 64 + m * 16 + fr) * DM + col)) = xn; } } }
        LAS float* P = (LAS float*)lds; LAS float* S = (LAS float*)(lds + 8192);
#pragma unroll
        for (int ai = 0; ai < 2; ++ai)
#pragma unroll
            for (int m = 0; m < 4; ++m) { float q = 0.f;
#pragma unroll
                for (int bj = 0; bj < 2; ++bj)
#pragma unroll
                    for (int n = 0; n < 2; ++n) { const f32x4 x = acc[ai][bj][m][n]; q += (x[0] * x[0] + x[1] * x[1]) + (x[2] * x[2] + x[3] * x[3]); }
                q += __shfl_xor(q, 16); q += __shfl_xor(q, 32);
                if (fq == 0) P[(ai * 128 + wr * 64 + m * 16 + fr) * 4 + wc] = q; }
        asm volatile("s_waitcnt lgkmcnt(0)" ::: "memory"); __builtin_amdgcn_s_barrier(); asm volatile("" ::: "memory");
        float* X = (float*)(wsb + WS_BIG + BIG_XCH); unsigned* cnt = (unsigned*)(wsb + WS_PCNT) + ((size_t)bank * 128 + u.pm) * 16;
        const int trow = wid * 64 + lane;
        if (wid < 4) { const float t = (P[trow * 4 + 0] + P[trow * 4 + 1]) + (P[trow * 4 + 2] + P[trow * 4 + 3]);
            __hip_atomic_store(X + (size_t)(row0 + trow) * 4 + u.pn, t, __ATOMIC_RELAXED, __HIP_MEMORY_SCOPE_AGENT);
            asm volatile("s_waitcnt vmcnt(0)" ::: "memory");
            if (lane == 0) (void)__hip_atomic_fetch_add(cnt, 1u, __ATOMIC_RELAXED, __HIP_MEMORY_SCOPE_AGENT); }
        if (wid == 0) { unsigned spin = 0;
            while ((unsigned)__builtin_amdgcn_readfirstlane((int)__hip_atomic_load(cnt, __ATOMIC_RELAXED, __HIP_MEMORY_SCOPE_AGENT)) < 16u) { __builtin_amdgcn_s_sleep(2); if (++spin > (1u << 22)) break; }
            __builtin_amdgcn_fence(__ATOMIC_ACQUIRE, "agent"); }
        asm volatile("s_waitcnt vmcnt(0) lgkmcnt(0)" ::: "memory"); __builtin_amdgcn_s_barrier(); asm volatile("" ::: "memory");
        if (wid < 4) { const float* xs = X + (size_t)(row0 + trow) * 4; float t = 0.f;
#pragma unroll
            for (int k = 0; k < 4; ++k) t += __hip_atomic_load(xs + k, __ATOMIC_RELAXED, __HIP_MEMORY_SCOPE_AGENT);
            S[trow] = rsqrtf(t * (1.f / DM) + 1e-6f); }
        asm volatile("s_waitcnt vmcnt(0) lgkmcnt(0)" ::: "memory"); __builtin_amdgcn_s_barrier(); asm volatile("" ::: "memory");
        const float* gain = (const float*)(wsb + WS_GAIN) + ((size_t)nlayer * 3 + nsub) * DM; const float* sh = MODb + ((size_t)nlayer * 9 + bidx) * NMODV + (3 * nsub) * DM;
        bf16* hb = (bf16*)(wsb + WS_H) + (size_t)row0 * DM;
#pragma unroll
        for (int ai = 0; ai < 2; ++ai)
#pragma unroll
            for (int m = 0; m < 4; ++m) { const float r = S[ai * 128 + wr * 64 + m * 16 + fr];
#pragma unroll
                for (int bj = 0; bj < 2; ++bj)
#pragma unroll
                    for (int n = 0; n < 2; ++n) acc[ai][bj][m][n] = acc[ai][bj][m][n] * r; }
        __builtin_amdgcn_sched_barrier(0);
#pragma unroll
        for (int bj = 0; bj < 2; ++bj)
#pragma unroll
            for (int n = 0; n < 2; ++n) { const int col = u.pn * 256 + bj * 128 + wc * 32 + 16 * n + 4 * fq;
                const f32x4 gv = *(const f32x4*)(gain + col) * (*(const f32x4*)(sh + DM + col) + 1.f), sf = *(const f32x4*)(sh + col);
#pragma unroll
                for (int ai = 0; ai < 2; ++ai)
#pragma unroll
                    for (int m = 0; m < 4; ++m) { const f32x4 o = acc[ai][bj][m][n] * gv + sf; u32x2 w; w.x = pk2(o[0], o[1]); w.y = pk2(o[2], o[3]);
                        *(u32x2*)(hb + (unsigned)((ai * 128 + wr * 64 + m * 16 + fr) * DM + col)) = w; } }
    }
};
struct EpiRopeN {
    static constexpr bool PERM = false, AFTER_DRAIN = false;
    bf16* O; const float* tab;
    __device__ __forceinline__ void operator()(const f32x4 (&acc)[2][2][4][2], const Unit& u, int wr, int wc, int fr_, int fq_) const {
        int fr = fr_, fq = fq_; asm volatile("" : "+v"(fr), "+v"(fq));
        if (u.pn >= 8) {
#pragma unroll
            for (int ai = 0; ai < 2; ++ai)
#pragma unroll
                for (int m = 0; m < 4; ++m) { const size_t row = (size_t)u.pm * 256 + ai * 128 + wr * 64 + m * 16 + fr;
#pragma unroll
                    for (int bj = 0; bj < 2; ++bj)
#pragma unroll
                        for (int n = 0; n < 2; ++n) { const int col = u.pn * 256 + bj * 128 + wc * 32 + 16 * n + 4 * fq; const f32x4 v = acc[ai][bj][m][n];
                            u32x2 w; w.x = pk2(v[0], v[1]); w.y = pk2(v[2], v[3]); *(u32x2*)(O + row * 4096 + col) = w; } }
            return;
        }
#pragma unroll
        for (int bj = 0; bj < 2; ++bj) { const int cc0 = u.pn * 256 + bj * 128 + wc * 32; const int sect = cc0 >> 10, hd = (cc0 & 1023) >> 8, s = (cc0 & 255) >> 7, gi = (cc0 & 127) >> 5;
            const int fi = 16 * gi + 4 * fq; const int c1 = sect * 1024 + hd * 256 + s * 128 + fi; const float sc = sect ? 0.0625f : 1.0f;
#pragma unroll
            for (int ai = 0; ai < 2; ++ai)
#pragma unroll
                for (int m = 0; m < 4; ++m) { const int row = u.pm * 256 + ai * 128 + wr * 64 + m * 16 + fr;
                    f32x4 cs = {1.f, 1.f, 1.f, 1.f}, sn = {0.f, 0.f, 0.f, 0.f};
                    if (row < NLAT) { const int t = row & 4095; const int pos = s ? (t & 63) : (t >> 6); cs = *(const f32x4*)(tab + pos * 64 + fi); sn = *(const f32x4*)(tab + 4096 + pos * 64 + fi); }
                    const f32x4 x1 = acc[ai][bj][m][0] * sc, x2 = acc[ai][bj][m][1] * sc; const f32x4 o1 = x1 * cs - x2 * sn, o2 = x1 * sn + x2 * cs;
                    u32x2 w; w.x = pk2(o1[0], o1[1]); w.y = pk2(o1[2], o1[3]); *(u32x2*)(O + (size_t)row * 4096 + c1) = w;
                    w.x = pk2(o2[0], o2[1]); w.y = pk2(o2[2], o2[3]); *(u32x2*)(O + (size_t)row * 4096 + c1 + 64) = w; } }
    }
};
struct EpiRopeT {
    static constexpr bool PERM = false, AFTER_DRAIN = false;
    bf16* O; const float* tab;
    __device__ __forceinline__ void operator()(const f32x4 (&acc)[2][2][4][2], const Unit& u, int wr, int wc, int fr_, int fq_) const {
        int fr = fr_, fq = fq_; asm volatile("" : "+v"(fr), "+v"(fq));
        if (u.pm >= 4) {
#pragma unroll
            for (int ai = 0; ai < 2; ++ai)
#pragma unroll
                for (int m = 0; m < 4; ++m) { const size_t row = (size_t)u.pm * 256 + ai * 128 + wr * 64 + m * 16 + fr;
#pragma unroll
                    for (int bj = 0; bj < 2; ++bj)
#pragma unroll
                        for (int n = 0; n < 2; ++n) { const int col = u.pn * 256 + bj * 128 + wc * 32 + 16 * n + 4 * fq; const f32x4 v = acc[ai][bj][m][n];
                            u32x2 w; w.x = pk2(v[0], v[1]); w.y = pk2(v[2], v[3]); *(u32x2*)(O + row * NTOK + col) = w; } }
            return;
        }
#pragma unroll
        for (int ai = 0; ai < 2; ++ai)
#pragma unroll
            for (int mp = 0; mp < 2; ++mp) { const int rb = u.pm * 256 + ai * 128 + wr * 64 + 32 * mp; const int hd = rb >> 8, s = (rb & 255) >> 7, gi = (rb & 127) >> 5; const int fi = 16 * gi + fr;
                const size_t r1 = (size_t)(hd * 256 + s * 128 + fi);
#pragma unroll
                for (int bj = 0; bj < 2; ++bj)
#pragma unroll
                    for (int n = 0; n < 2; ++n) { const int col = u.pn * 256 + bj * 128 + wc * 32 + 16 * n + 4 * fq;
                        f32x4 cs = {1.f, 1.f, 1.f, 1.f}, sn = {0.f, 0.f, 0.f, 0.f};
                        if (col < NLAT) {
#pragma unroll
                            for (int j = 0; j < 4; ++j) { const int t = (col + j) & 4095; const int pos = s ? (t & 63) : (t >> 6); cs[j] = tab[pos * 64 + fi]; sn[j] = tab[4096 + pos * 64 + fi]; } }
                        const f32x4 x1 = acc[ai][bj][2 * mp][n] * 0.0625f, x2 = acc[ai][bj][2 * mp + 1][n] * 0.0625f; const f32x4 o1 = x1 * cs - x2 * sn, o2 = x1 * sn + x2 * cs;
                        u32x2 w; w.x = pk2(o1[0], o1[1]); w.y = pk2(o1[2], o1[3]); *(u32x2*)(O + r1 * NTOK + col) = w;
                        w.x = pk2(o2[0], o2[1]); w.y = pk2(o2[2], o2[3]); *(u32x2*)(O + (r1 + 64) * NTOK + col) = w; } }
    }
};
struct EpiGate {
    static constexpr bool PERM = false, AFTER_DRAIN = false;
    bf16* Y; const float* stats;
    __device__ __forceinline__ void operator()(const f32x4 (&acc)[2][2][4][2], const Unit& u, int wr, int wc, int fr_, int fq_) const {
        int fr = fr_, fq = fq_; asm volatile("" : "+v"(fr), "+v"(fq));
        const int head = u.pn >> 1;
#pragma unroll
        for (int ai = 0; ai < 2; ++ai)
#pragma unroll
            for (int m = 0; m < 4; ++m) { const size_t row = (size_t)u.pm * 256 + ai * 128 + wr * 64 + m * 16 + fr;
                const float mu = stats[row * 8 + head * 2], rs = stats[row * 8 + head * 2 + 1];
#pragma unroll
                for (int bj = 0; bj < 2; ++bj)
#pragma unroll
                    for (int n = 0; n < 2; ++n) { const int col = u.pn * 256 + bj * 128 + wc * 32 + 16 * n + 4 * fq; const f32x4 v = acc[ai][bj][m][n];
                        u32x2* p = (u32x2*)(Y + row * 2048 + col); const u32x2 y = *p;
                        u32x2 w; w.x = pk2(siluf(v[0]) * (bflo(y.x) - mu) * rs, siluf(v[1]) * (bfhi(y.x) - mu) * rs); w.y = pk2(siluf(v[2]) * (bflo(y.y) - mu) * rs, siluf(v[3]) * (bfhi(y.y) - mu) * rs); *p = w; } }
    }
};
__device__ __forceinline__ float wave_sum(float v) {
#pragma unroll
    for (int o = 1; o < 64; o <<= 1) v += __shfl_xor(v, o);
    return v;
}
template <int MAP> __device__ __forceinline__ int rowmap(int n) {
    if (MAP == 1) { const int sec = n >= DFF ? 1 : 0, hh = n - sec * DFF, hl = hh & 127; return 256 * (hh >> 7) + 128 * ((hl & 7) >> 2) + 32 * (hl >> 5) + 16 * sec + 4 * ((hl & 31) >> 3) + (hl & 3); }
    if (MAP == 2) { if (n >= 2048) return n; const int d = n & 255, qd = d >> 6, fi = d & 63; return (n - d) + (qd >> 1) * 128 + 32 * (fi >> 4) + 16 * (qd & 1) + (fi & 15); }
    return n;
}
template <int MAP> __device__ __forceinline__ void transpose_item(const float* W, int K, int N, bf16* WT, LAS float* scr, int item, int lane) {
    const int nblk = N / 32, kb = item / nblk, nb = item % nblk, k0 = 64 * kb, n0 = 32 * nb;
#pragma unroll 8
    for (int i = 0; i < 32; ++i) { const int kk = 2 * i + (lane >> 5); scr[kk * 33 + (lane & 31)] = W[(size_t)(k0 + kk) * N + n0 + (lane & 31)]; }
    asm volatile("s_waitcnt lgkmcnt(0)" ::: "memory");
    const int c = lane & 7;
#pragma unroll
    for (int j = 0; j < 4; ++j) { const int n = (lane >> 3) + 8 * j; const LAS float* s = scr + (8 * c) * 33 + n;
        u32x4 o; o.x = pk2(s[0 * 33], s[1 * 33]); o.y = pk2(s[2 * 33], s[3 * 33]); o.z = pk2(s[4 * 33], s[5 * 33]); o.w = pk2(s[6 * 33], s[7 * 33]);
        *(u32x4*)(WT + (size_t)rowmap<MAP>(n0 + n) * K + k0 + 8 * c) = o; }
    asm volatile("s_waitcnt lgkmcnt(0)" ::: "memory");
}

__device__ __forceinline__ void phase_prologue(const KArgs& a, LAS unsigned char* lds) {
    const int tid = TIDX(), G = gridDim.x, bid = BIDX();
    {
        const f32x4* cs = (const f32x4*)AIN(a, 2); f32x4* cd = (f32x4*)(WSB(a) + WS_XC);
        for (size_t i = (size_t)bid * 512 + tid; i < (size_t)NCTX * DM / 4; i += (size_t)G * 512) cd[i] = cs[i];
    }
    { float* gd = (float*)(WSB(a) + WS_GAIN); for (int i = bid * 512 + tid; i < 4 * 3 * DM; i += G * 512) gd[i] = AIN(a, 6)[i]; }
    {
        float* tab = (float*)(WSB(a) + WS_TAB);
        for (int i = bid * 512 + tid; i < 4096; i += G * 512) { const int pos = i >> 6, f = i & 63; const float inv = powf(10000.f, -(float)f / 64.f); const float ang = (float)pos * inv; tab[i] = cosf(ang); tab[4096 + i] = sinf(ang); }
    }
    LAS float* sv = (LAS float*)lds;
    LAS float* red = (LAS float*)(lds + 36864);
    for (int i = tid; i < 9 * DM; i += 512) { const float v = i < 8 * DM ? AIN(a, 1)[i] : AIN(a, 3)[i - 8 * DM]; sv[i] = siluf(v); }
    __syncthreads();
    const int wave = tid >> 6, lane = tid & 63;
    float* MOD = (float*)(WSB(a) + WS_MOD);
    for (int item = bid; item < 4 * (NMODV / 64); item += G) {
        const int layer = item / (NMODV / 64), cb = item % (NMODV / 64); const int col = cb * 64 + lane;
        const float* W = AIN(a, 4) + (size_t)layer * DM * NMODV + col;
        float acc[9];
#pragma unroll
        for (int r = 0; r < 9; ++r) acc[r] = 0.f;
#pragma unroll 4
        for (int kk = 0; kk < 128; ++kk) { const int k = wave * 128 + kk; const float w = W[(size_t)k * NMODV];
#pragma unroll
            for (int r = 0; r < 9; ++r) acc[r] += sv[r * DM + k] * w; }
#pragma unroll
        for (int r = 0; r < 9; ++r) red[(wave * 9 + r) * 64 + lane] = acc[r];
        __syncthreads();
        for (int o = tid; o < 9 * 64; o += 512) { const int r = o >> 6, l = o & 63; float s = 0.f;
#pragma unroll
            for (int w = 0; w < 8; ++w) s += red[(w * 9 + r) * 64 + l];
            MOD[((size_t)layer * 9 + r) * NMODV + cb * 64 + l] = s + AIN(a, 5)[(size_t)layer * NMODV + cb * 64 + l]; }
        __syncthreads();
    }
}

__device__ __forceinline__ void phase_weights(const KArgs& a, LAS unsigned char* lds, int layer) {
    const int wave = TIDX() >> 6, lane = TIDX() & 63; const int gw = BIDX() * 8 + wave, NGW = gridDim.x * 8;
    LAS float* scr = (LAS float*)(lds + wave * 16384);
    unsigned char* wb = WSB(a) + WS_W; const int e = layer >> 1;
    const int I_IN = 16 * (2 * DFF / 32), I_OUT = (DFF / 64) * 32;
    const bool even = (layer & 1) == 0;
    const int I_MI = even ? 16 * (3072 / 32) : 16 * (6144 / 32), I_MO = even ? 16 * 32 : 32 * 32;
    const int total = 2 * I_IN + 2 * I_OUT + I_MI + I_MO;
    for (int it = gw; it < total; it += NGW) {
        int r = it;
        if (r < I_IN) { transpose_item<1>(AIN(a, 7) + (size_t)layer * DM * 2 * DFF, DM, 2 * DFF, (bf16*)(wb + W_AIN), scr, r, lane); continue; } r -= I_IN;
        if (r < I_IN) { transpose_item<1>(AIN(a, 9) + (size_t)layer * DM * 2 * DFF, DM, 2 * DFF, (bf16*)(wb + W_BIN), scr, r, lane); continue; } r -= I_IN;
        if (r < I_OUT) { transpose_item<0>(AIN(a, 8) + (size_t)layer * DFF * DM, DFF, DM, (bf16*)(wb + W_AOUT), scr, r, lane); continue; } r -= I_OUT;
        if (r < I_OUT) { transpose_item<0>(AIN(a, 10) + (size_t)layer * DFF * DM, DFF, DM, (bf16*)(wb + W_BOUT), scr, r, lane); continue; } r -= I_OUT;
        if (even) {
            if (r < I_MI) { transpose_item<0>(AIN(a, 11) + (size_t)e * DM * 3072, DM, 3072, (bf16*)(wb + W_MIN), scr, r, lane); continue; } r -= I_MI;
            transpose_item<0>(AIN(a, 12) + (size_t)e * DM * DM, DM, DM, (bf16*)(wb + W_MOUT), scr, r, lane);
        } else {
            if (r < I_MI) { transpose_item<2>(AIN(a, 27) + (size_t)e * DM * 6144, DM, 6144, (bf16*)(wb + W_MIN), scr, r, lane); continue; } r -= I_MI;
            transpose_item<0>(AIN(a, 28) + (size_t)e * 2048 * DM, 2048, DM, (bf16*)(wb + W_MOUT), scr, r, lane);
        }
    }
}

template <int NR> __device__ __forceinline__ void normmod_rows(const KArgs& a, const float* gain, const float* MOD, bf16* H, int sub, int row0, int rstride, int nrows, int lane, bool pending, bool first = false) {
    f32x4 v[NR][4]; float s[NR];
#pragma unroll
    for (int rr = 0; rr < NR; ++rr) { const int row = row0 + rr * rstride;
        if (row < nrows) { const float* xr = row < NLAT ? (first ? AIN(a, 0) : a.out) + (size_t)row * DM : (const float*)(WSB(a) + WS_XC) + (size_t)(row - NLAT) * DM;
#pragma unroll
            for (int j = 0; j < 4; ++j) v[rr][j] = *(const f32x4*)(xr + 256 * j + 4 * lane); }
        else {
#pragma unroll
            for (int j = 0; j < 4; ++j) v[rr][j] = (f32x4){0.f, 0.f, 0.f, 0.f}; } }
#pragma unroll
    for (int rr = 0; rr < NR; ++rr) { const int row = row0 + rr * rstride;
        if (row >= NLAT && row < nrows && pending) {
            const float* pp = (const float*)(WSB(a) + WS_BIG + BIG_PART) + (size_t)(row - NLAT) * DM + 4 * lane;
#pragma unroll
            for (int sp = 0; sp < 4; ++sp)
#pragma unroll
                for (int j = 0; j < 4; ++j) v[rr][j] += *(const f32x4*)(pp + (size_t)sp * NCTX * DM + 256 * j);
#pragma unroll
            for (int j = 0; j < 4; ++j) *(f32x4*)((float*)(WSB(a) + WS_XC) + (size_t)(row - NLAT) * DM + 256 * j + 4 * lane) = v[rr][j];
        }
        float q = 0.f;
#pragma unroll
        for (int j = 0; j < 4; ++j) q += (v[rr][j][0] * v[rr][j][0] + v[rr][j][1] * v[rr][j][1]) + (v[rr][j][2] * v[rr][j][2] + v[rr][j][3] * v[rr][j][3]);
        s[rr] = q; }
#pragma unroll
    for (int o = 1; o < 64; o <<= 1) {
#pragma unroll
        for (int rr = 0; rr < NR; ++rr) s[rr] += __shfl_xor(s[rr], o); }
#pragma unroll
    for (int j = 0; j < 4; ++j) { const int c = 256 * j + 4 * lane; const f32x4 g = *(const f32x4*)(gain + c);
#pragma unroll
        for (int rr = 0; rr < NR; ++rr) { const int row = row0 + rr * rstride;
            if (row < nrows) { const int bidx = row < NLAT ? (row >> 12) : 8; const float* sh = MOD + (size_t)bidx * NMODV + (3 * sub) * DM;
                const f32x4 sc = *(const f32x4*)(sh + DM + c), sf = *(const f32x4*)(sh + c); const float rstd = rsqrtf(s[rr] * (1.f / DM) + 1e-6f);
                const f32x4 o = v[rr][j] * rstd * g * (sc + 1.f) + sf; u32x2 w; w.x = pk2(o[0], o[1]); w.y = pk2(o[2], o[3]); *(u32x2*)(H + (size_t)row * DM + c) = w; } } }
}
__device__ __forceinline__ void phase_normmod(const KArgs& a, int layer, int sub, int nrows = NTOK, bool pending = true, int rbeg = 0) {
    const int wave = TIDX() >> 6, lane = TIDX() & 63; const int gw = BIDX() * 8 + wave, NGW = gridDim.x * 8;
    const float* gain = AIN(a, 6) + ((size_t)layer * 3 + sub) * DM; const float* MOD = (const float*)(WSB(a) + WS_MOD) + (size_t)layer * 9 * NMODV;
    bf16* H = (bf16*)(WSB(a) + WS_H);
    for (int row = rbeg + gw; row < nrows; row += 4 * NGW) normmod_rows<4>(a, gain, MOD, H, sub, row, NGW, nrows, lane, pending, layer == 0 && sub == 0);
}

__device__ __forceinline__ void phase_filter(const KArgs& a, int e) {
    const int wave = TIDX() >> 6, lane = TIDX() & 63; const int gw = BIDX() * 8 + wave, NGW = gridDim.x * 8;
    const float* fw1 = AIN(a, 18) + (size_t)e * 17 * 64; const float* fb1 = AIN(a, 19) + e * 64; const float* fw2 = AIN(a, 20) + (size_t)e * 4096; const float* fb2 = AIN(a, 21) + e * 64;
    const float* fw3 = AIN(a, 22) + (size_t)e * 4096; const float* fb3 = AIN(a, 23) + e * 64; const float* fw4 = AIN(a, 24) + (size_t)e * 64 * 1024; const float fr = AIN(a, 25)[e * 64 + lane];
    for (int p = gw; p < SEQ + CTXL; p += NGW) {
        const bool lat = p < SEQ; const int L = lat ? SEQ : CTXL, ti = lat ? p : p - SEQ; const int P = 2 * L + 16;
        bf16* GI = (bf16*)(WSB(a) + (lat ? WS_GIL : WS_GIC));
        const float tt = (float)ti / (float)(L - 1); const float w = 6.283185307179586f * (float)ti / (float)L;
        float h = tt * fw1[lane];
#pragma unroll
        for (int k = 0; k < 8; ++k) { const float band = 1e-4f + (float)k * ((7.0f - 1e-4f) / 7.0f); const float ang = band * w; h += cosf(ang) * fw1[(1 + k) * 64 + lane] - sinf(ang) * fw1[(9 + k) * 64 + lane]; }
        h = sinf(fr * (h + fb1[lane]));
        float h2 = fb2[lane];
        for (int k = 0; k < 64; ++k) h2 += __shfl(h, k) * fw2[k * 64 + lane];
        h2 = sinf(fr * h2);
        float h3 = fb3[lane];
        for (int k = 0; k < 64; ++k) h3 += __shfl(h2, k) * fw3[k * 64 + lane];
        h3 = sinf(fr * h3);
        float o[16];
#pragma unroll
        for (int j = 0; j < 16; ++j) o[j] = 0.f;
        for (int k = 0; k < 64; ++k) { const float hk = __shfl(h3, k);
#pragma unroll
            for (int j = 0; j < 16; ++j) o[j] += hk * fw4[k * 1024 + 64 * j + lane]; }
        const float maxd = -15.350567286626973f, mind = -3.0701134573253945f;
#pragma unroll
        for (int j = 0; j < 8; ++j) { const int c = 64 * j + lane; const float delta = mind + (float)c * ((maxd - mind) / 511.f); const float win = expf(-tt * fabsf(delta));
            const float hf = o[j] * win, hb = o[j + 8] * win; bf16* g = GI + (size_t)c * P;
            if (ti == 0) { g[L + 15] = (bf16)f2bf(hf + hb); for (int u = 0; u < 16; ++u) g[u] = 0; g[2 * L + 15] = 0; }
            else { g[L + 15 - ti] = (bf16)f2bf(hf); g[L + 15 + ti] = (bf16)f2bf(hb); } }
    }
}
__device__ __forceinline__ void phase_qknorm(const KArgs& a, int e) {
    const int wave = TIDX() >> 6, lane = TIDX() & 63; const int gw = BIDX() * 8 + wave, NGW = gridDim.x * 8;
    bf16* QK = (bf16*)(WSB(a) + WS_BIG + EV_QK);
    const int grp = lane >> 2; const float* gp = (grp < 8 ? AIN(a, 13) : AIN(a, 14)) + e * 64 + 16 * (lane & 3); const float extra = grp < 8 ? 0.125f : 1.0f;
    float g[16];
#pragma unroll
    for (int j = 0; j < 16; ++j) g[j] = gp[j] * extra;
    for (int row = gw; row < NTOK; row += NGW) {
        u32x4* p = (u32x4*)(QK + (size_t)row * 1024 + 16 * lane); u32x4 v0 = p[0], v1 = p[1];
        float x[16];
#pragma unroll
        for (int j = 0; j < 4; ++j) { x[2 * j] = bflo(v0[j]); x[2 * j + 1] = bfhi(v0[j]); x[8 + 2 * j] = bflo(v1[j]); x[9 + 2 * j] = bfhi(v1[j]); }
        float s = 0.f;
#pragma unroll
        for (int j = 0; j < 16; ++j) s += x[j] * x[j];
        s += __shfl_xor(s, 1); s += __shfl_xor(s, 2);
        const float rstd = rsqrtf(s * (1.f / 64.f) + 1e-6f);
#pragma unroll
        for (int j = 0; j < 4; ++j) { v0[j] = pk2(x[2 * j] * rstd * g[2 * j], x[2 * j + 1] * rstd * g[2 * j + 1]); v1[j] = pk2(x[8 + 2 * j] * rstd * g[8 + 2 * j], x[9 + 2 * j] * rstd * g[9 + 2 * j]); }
        p[0] = v0; p[1] = v1;
    }
}

template <bool WIN> __device__ __forceinline__ int attn_ktok(int t, int b, int rs, int kb, int ctok0) {
    if (WIN && t < 16) return b * SEQ + (rs + (t >> 1)) * 64 + kb + 4 * (t & 1);
    return ctok0 + 32 * ((WIN ? t - 16 : t) >> 1) + 4 * (t & 1);
}
template <bool WIN> __device__ __forceinline__ void attn_loadk(bf16x8 (&kf)[4][2], const bf16* QK, const LAS bf16* CK, int grp, int b, int h, int rs, int kb, int ctok0, int li, int g) {
    if (WIN && grp >= 4) {
#pragma unroll
        for (int q = 0; q < 4; ++q) { const int t = grp * 4 + q - 16; const LAS bf16* kp = CK + (32 * (t >> 1) + 4 * (t & 1) + 8 * (li >> 2) + (li & 3)) * 72 + 8 * g; kf[q][0] = *(const LAS bf16x8*)kp; kf[q][1] = *(const LAS bf16x8*)(kp + 32); }
        return;
    }
#pragma unroll
    for (int q = 0; q < 4; ++q) { const bf16* kp = QK + (unsigned)((attn_ktok<WIN>(grp * 4 + q, b, rs, kb, ctok0) + 8 * (li >> 2) + (li & 3)) * 1024 + 512 + h * 64 + 8 * g); kf[q][0] = *(const bf16x8*)kp; kf[q][1] = *(const bf16x8*)(kp + 32); }
}
template <bool WIN> __device__ __forceinline__ void attn_loadv(bf16x8 (&vf)[4], const bf16* VT, const LAS bf16* CV, int t2, int b, int h, int rs, int kb, int ctok0, int li, int g) {
    if (WIN && t2 >= 8) {
#pragma unroll
        for (int dt = 0; dt < 4; ++dt) vf[dt] = *(const LAS bf16x8*)(CV + (16 * dt + li) * 264 + 32 * (t2 - 8) + 8 * g);
        return;
    }
    const int tb = (WIN && t2 < 8) ? b * SEQ + (rs + t2) * 64 + kb : ctok0 + 32 * (WIN ? t2 - 8 : t2);
#pragma unroll
    for (int dt = 0; dt < 4; ++dt) vf[dt] = *(const bf16x8*)(VT + (unsigned)((h * 64 + 16 * dt + li) * NTOK + tb + 8 * g));
}
template <bool WIN> __device__ __forceinline__ void attn_wave(const bf16* QK, const bf16* VT, bf16* CAT, const LAS float* rpbL, const LAS bf16* CK, const LAS bf16* CV, int b, int h, int r, int c0, int qtok0, int lane) {
    const int li = lane & 15, g = lane >> 4;
    constexpr int NT = WIN ? 32 : 16, NG = NT / 4;
    bf16x8 qf[2];
    { const bf16* qp = QK + (unsigned)((qtok0 + li) * 1024 + h * 64 + 8 * g); qf[0] = *(const bf16x8*)qp; qf[1] = *(const bf16x8*)(qp + 32); }
    const int rs = WIN ? min(max(r - 4, 0), 56) : 0, kb = WIN ? min(max(c0 - 8, 0), 32) : 0;
    const int ctok0 = NLAT + b * CTXL;
    f32x4 sc[NT];
    bf16x8 kfa[4][2], kfb[4][2];
    attn_loadk<WIN>(kfa, QK, CK, 0, b, h, rs, kb, ctok0, li, g);
#pragma unroll
    for (int grp = 0; grp < NG; ++grp) {
        if (grp + 1 < NG) { if (grp & 1) attn_loadk<WIN>(kfa, QK, CK, grp + 1, b, h, rs, kb, ctok0, li, g); else attn_loadk<WIN>(kfb, QK, CK, grp + 1, b, h, rs, kb, ctok0, li, g); }
#pragma unroll
        for (int q = 0; q < 4; ++q) { const int t = grp * 4 + q;
            f32x4 acc = {0.f, 0.f, 0.f, 0.f};
            if (grp & 1) { acc = mfma16(kfb[q][0], qf[0], acc); acc = mfma16(kfb[q][1], qf[1], acc); } else { acc = mfma16(kfa[q][0], qf[0], acc); acc = mfma16(kfa[q][1], qf[1], acc); }
            if (WIN && t < 16) {
                const int qc = c0 + li, cs = min(max(qc - 8, 0), 48); const int dr = rs + (t >> 1) - r + 7;
#pragma unroll
                for (int j = 0; j < 4; ++j) { const int kc = kb + 8 * g + 4 * (t & 1) + j; const bool ok = kc >= cs && kc < cs + 16;
                    const int dc = min(max(kc - qc + 15, 0), 30); const float bias = rpbL[dr * 31 + dc]; acc[j] = ok ? acc[j] + bias : -1e30f; }
            }
            sc[t] = acc; }
        __builtin_amdgcn_sched_barrier(0);
    }
    bf16x8 vfa[4], vfb[4];
    attn_loadv<WIN>(vfa, VT, CV, 0, b, h, rs, kb, ctok0, li, g);
    attn_loadv<WIN>(vfb, VT, CV, 1, b, h, rs, kb, ctok0, li, g);
    float mx = -1e30f;
#pragma unroll
    for (int t = 0; t < NT; ++t) mx = fmaxf(mx, fmaxf(fmaxf(sc[t][0], sc[t][1]), fmaxf(sc[t][2], sc[t][3])));
    mx = fmaxf(mx, __shfl_xor(mx, 16)); mx = fmaxf(mx, __shfl_xor(mx, 32));
    float sum = 0.f;
#pragma unroll
    for (int t = 0; t < NT; ++t) {
#pragma unroll
        for (int j = 0; j < 4; ++j) { const float p = __expf(sc[t][j] - mx); sc[t][j] = p; sum += p; } }
    sum += __shfl_xor(sum, 16); sum += __shfl_xor(sum, 32);
    const float inv = 1.f / sum;
    f32x4 o[4];
#pragma unroll
    for (int dt = 0; dt < 4; ++dt) o[dt] = (f32x4){0.f, 0.f, 0.f, 0.f};
#pragma unroll
    for (int t2 = 0; t2 < NT / 2; ++t2) {
        union { u32x4 u; bf16x8 v; } pf; pf.u.x = pk2(sc[2 * t2][0], sc[2 * t2][1]); pf.u.y = pk2(sc[2 * t2][2], sc[2 * t2][3]); pf.u.z = pk2(sc[2 * t2 + 1][0], sc[2 * t2 + 1][1]); pf.u.w = pk2(sc[2 * t2 + 1][2], sc[2 * t2 + 1][3]);
#pragma unroll
        for (int dt = 0; dt < 4; ++dt) o[dt] = mfma16((t2 & 1) ? vfb[dt] : vfa[dt], pf.v, o[dt]);
        if (t2 + 2 < NT / 2) { if (t2 & 1) attn_loadv<WIN>(vfb, VT, CV, t2 + 2, b, h, rs, kb, ctok0, li, g); else attn_loadv<WIN>(vfa, VT, CV, t2 + 2, b, h, rs, kb, ctok0, li, g); }
        __builtin_amdgcn_sched_barrier(0);
    }
#pragma unroll
    for (int dt = 0; dt < 4; ++dt) { u32x2 w; w.x = pk2(o[dt][0] * inv, o[dt][1] * inv); w.y = pk2(o[dt][2] * inv, o[dt][3] * inv);
        *(u32x2*)(CAT + (unsigned)((qtok0 + li) * 1024 + h * 64 + 16 * dt + 4 * g)) = w; }
}
__device__ __forceinline__ void phase_attn(const KArgs& a, LAS unsigned char* lds, int e) {
    const int tid = TIDX(), wave = __builtin_amdgcn_readfirstlane(tid >> 6), lane = tid & 63;
    const bf16* QK = (const bf16*)(WSB(a) + WS_BIG + EV_QK); const bf16* VT = (const bf16*)(WSB(a) + WS_BIG + EV_UT); bf16* CAT = (bf16*)(WSB(a) + WS_BIG + EV_CAT);
    LAS float* rpbL = (LAS float*)lds; LAS bf16* CKs = (LAS bf16*)(lds + 2048); LAS bf16* CVs = (LAS bf16*)(lds + 2048 + 36864);
    for (int bt = BIDX(); bt < 2048 + 128; bt += gridDim.x) {
        if (bt < 2048) { const int b = bt >> 8, h = (bt >> 5) & 7, rp = bt & 31; const int r = 2 * rp + (wave >> 2), c0 = 16 * (wave & 3);
            __syncthreads();
            if (tid < 465) rpbL[tid] = AIN(a, 15)[((size_t)e * 8 + h) * 465 + tid];
            { const int ctok0 = NLAT + b * CTXL;
              int tl = tid; asm volatile("" : "+v"(tl));
#pragma unroll
              for (int i = 0; i < 4; ++i) { const int pid = tl + 512 * i; *(LAS u32x4*)(CKs + (pid >> 3) * 72 + 8 * (pid & 7)) = *(const u32x4*)(QK + (unsigned)((ctok0 + (pid >> 3)) * 1024 + 512 + h * 64 + 8 * (pid & 7))); }
#pragma unroll
              for (int i = 0; i < 4; ++i) { const int pid = tl + 512 * i; *(LAS u32x4*)(CVs + (pid >> 5) * 264 + 8 * (pid & 31)) = *(const u32x4*)(VT + (unsigned)((h * 64 + (pid >> 5)) * NTOK + ctok0 + 8 * (pid & 31))); } }
            __syncthreads();
            attn_wave<true>(QK, VT, CAT, rpbL, CKs, CVs, b, h, r, c0, b * SEQ + r * 64 + c0, lane); }
        else { const int wt = (bt - 2048) * 8 + wave; const int b = wt >> 7, h = (wt >> 4) & 7, qt = wt & 15;
            attn_wave<false>(QK, VT, CAT, rpbL, CKs, CVs, b, h, 0, 0, NLAT + b * CTXL + 16 * qt, lane); }
    }
    __syncthreads();
}

__device__ __forceinline__ float sconv(const bf16* row, int tok, int t, int L, float w0, float w1, float w2, float bias) {
    const float um = t > 0 ? bf2f(row[tok - 1]) : 0.f, u0 = bf2f(row[tok]), up = t < L - 1 ? bf2f(row[tok + 1]) : 0.f;
    return um * w0 + u0 * w1 + up * w2 + bias;
}
template <int L> __device__ __forceinline__ void hyena_task(const KArgs& a, LAS unsigned char* lds, int e, int c) {
    constexpr int ZP = SEQ + 64, P = 2 * L + 16, NT = L / 32, TPW = NT / 8;
    const int tid = TIDX(), wave = tid >> 6, lane = tid & 63, li = lane & 15, g = lane >> 4;
    LAS bf16* ZT = (LAS bf16*)lds; LAS bf16* GI = (LAS bf16*)(lds + 8 * ZP * 2);
    const bf16* UT = (const bf16*)(WSB(a) + WS_BIG + EV_UT); bf16* BT = (bf16*)(WSB(a) + WS_BIG + EV_BT);
    const float* cw = AIN(a, 16) + (size_t)e * 3 * 1536; const float* cb = AIN(a, 17) + e * 1536;
    const int tokbase = L == SEQ ? 0 : NLAT;
    {
        const float a0 = cw[512 + c], a1 = cw[1536 + 512 + c], a2 = cw[3072 + 512 + c], ab = cb[512 + c];
        const float v0 = cw[1024 + c], v1 = cw[1536 + 1024 + c], v2 = cw[3072 + 1024 + c], vb = cb[1024 + c];
        const bf16* r1 = UT + (size_t)(1024 + c) * NTOK; const bf16* rv = UT + (size_t)(1536 + c) * NTOK;
#pragma unroll 4
        for (int idx = tid; idx < L; idx += 512) { const int b = idx / (L / 8), t0 = 8 * (idx % (L / 8)); const int tok = tokbase + b * L + t0;
            const u32x4 xa = *(const u32x4*)(r1 + tok), xv = *(const u32x4*)(rv + tok);
            const float al = t0 > 0 ? bf2f(r1[tok - 1]) : 0.f, ar = t0 + 8 < L ? bf2f(r1[tok + 8]) : 0.f, vl = t0 > 0 ? bf2f(rv[tok - 1]) : 0.f, vr = t0 + 8 < L ? bf2f(rv[tok + 8]) : 0.f;
            float xs[10], vs[10]; xs[0] = al; xs[9] = ar; vs[0] = vl; vs[9] = vr;
#pragma unroll
            for (int j = 0; j < 4; ++j) { xs[1 + 2 * j] = bflo(xa[j]); xs[2 + 2 * j] = bfhi(xa[j]); vs[1 + 2 * j] = bflo(xv[j]); vs[2 + 2 * j] = bfhi(xv[j]); }
            float z[8];
#pragma unroll
            for (int j = 0; j < 8; ++j) z[j] = (vs[j] * v0 + vs[j + 1] * v1 + vs[j + 2] * v2 + vb) * (xs[j] * a0 + xs[j + 1] * a1 + xs[j + 2] * a2 + ab);
            u32x4 w; w.x = pk2(z[0], z[1]); w.y = pk2(z[2], z[3]); w.z = pk2(z[4], z[5]); w.w = pk2(z[6], z[7]);
            *(LAS u32x4*)(ZT + b * ZP + 32 + t0) = w; }
        for (int idx = tid; idx < 8 * 32; idx += 512) { const int b = idx >> 5, p = idx & 31; ZT[b * ZP + p] = 0; ZT[b * ZP + 32 + L + p] = 0; }
        const u32x4* gs = (const u32x4*)((const bf16*)(WSB(a) + (L == SEQ ? WS_GIL : WS_GIC)) + (size_t)c * P); LAS u32x4* gd = (LAS u32x4*)GI;
        for (int idx = tid; idx < P / 8; idx += 512) gd[idx] = gs[idx];
    }
    __syncthreads();
    f32x4 acc[TPW];
#pragma unroll
    for (int q = 0; q < TPW; ++q) acc[q] = (f32x4){0.f, 0.f, 0.f, 0.f};
    const int bb = li & 7, tt = li >> 3;
    if constexpr (TPW == 16) {
        const int T0 = wave * 16;
        bf16x8 W[16];
#pragma unroll
        for (int j = 0; j < 16; ++j) W[j] = (bf16x8){0, 0, 0, 0, 0, 0, 0, 0};
        const LAS bf16* zb = ZT + bb * ZP + 32 + 16 * tt + 8 * g;
        const LAS bf16* gb = GI + (L + 15 - li + 8 * g - 32 * (T0 + 16));
        for (int blk = 0; blk < 9; ++blk) {
#pragma unroll
            for (int s16 = 0; s16 < 16; ++s16) {
                const int sg = blk * 16 + s16;
                W[(s16 + 15) & 15] = sg <= 128 ? *(const LAS bf16x8*)(zb + 32 * (sg - 1)) : (bf16x8){0, 0, 0, 0, 0, 0, 0, 0};
                union { unsigned short s[8]; bf16x8 v; } af; const LAS bf16* gp = gb + 32 * sg;
#pragma unroll
                for (int j = 0; j < 8; ++j) af.s[j] = gp[j];
#pragma unroll
                for (int q = 0; q < 16; ++q) acc[q] = mfma16(af.v, W[(q + s16) & 15], acc[q]);
            }
        }
    } else {
    for (int dq = 0; dq < 2 * L / 32; ++dq) {
        const int dl = -L + 32 * dq;
        const int T0 = wave * TPW;
        if (dl < -32 * (T0 + TPW - 1) - 32 || dl > L - 32 - 32 * T0) continue;
        union { unsigned short s[8]; bf16x8 v; } af; const LAS bf16* gp = GI + (L + 15 - li + dl + 8 * g);
#pragma unroll
        for (int j = 0; j < 8; ++j) af.s[j] = gp[j];
#pragma unroll
        for (int q = 0; q < TPW; ++q) { const int T = T0 + q;
            if (dl >= -32 * T - 32 && dl <= L - 32 - 32 * T) { const bf16x8 bv = *(const LAS bf16x8*)(ZT + bb * ZP + 32 + 32 * T + 16 * tt + dl + 8 * g); acc[q] = mfma16(af.v, bv, acc[q]); } }
    }
    }
    {
        const float a0 = cw[c], a1 = cw[1536 + c], a2 = cw[3072 + c], ab = cb[c]; const float dbias = AIN(a, 26)[e * 512 + c];
        const bf16* r0 = UT + (size_t)(512 + c) * NTOK;
#pragma unroll
        for (int q = 0; q < TPW; ++q) { const int T = wave * TPW + q; const int t0 = 32 * T + 16 * tt + 4 * g; const int tok = tokbase + bb * L + t0;
            const u32x2 xx = *(const u32x2*)(r0 + tok); const u32x2 zz = *(const LAS u32x2*)(ZT + bb * ZP + 32 + t0);
            float xs[6]; xs[0] = t0 > 0 ? bf2f(r0[tok - 1]) : 0.f; xs[5] = t0 + 4 < L ? bf2f(r0[tok + 4]) : 0.f; xs[1] = bflo(xx.x); xs[2] = bfhi(xx.x); xs[3] = bflo(xx.y); xs[4] = bfhi(xx.y);
            const float zf[4] = {bflo(zz.x), bfhi(zz.x), bflo(zz.y), bfhi(zz.y)};
            float o[4];
#pragma unroll
            for (int j = 0; j < 4; ++j) o[j] = (acc[q][j] + zf[j] * dbias) * (xs[j] * a0 + xs[j + 1] * a1 + xs[j + 2] * a2 + ab);
            u32x2 w; w.x = pk2(o[0], o[1]); w.y = pk2(o[2], o[3]); *(u32x2*)(BT + (size_t)c * NTOK + tok) = w; }
    }
    __syncthreads();
}
__device__ __forceinline__ void phase_hyena(const KArgs& a, LAS unsigned char* lds, int e) {
    for (int task = BIDX(); task < 1024; task += gridDim.x) { if (task < 512) hyena_task<SEQ>(a, lds, e, task); else hyena_task<CTXL>(a, lds, e, task - 512); }
}
__device__ __forceinline__ void phase_bt_transpose(const KArgs& a, LAS unsigned char* lds) {
    const int wave = TIDX() >> 6, lane = TIDX() & 63; const int gw = BIDX() * 8 + wave, NGW = gridDim.x * 8;
    LAS bf16* scr = (LAS bf16*)(lds + wave * 16384);
    const bf16* BT = (const bf16*)(WSB(a) + WS_BIG + EV_BT); bf16* CAT = (bf16*)(WSB(a) + WS_BIG + EV_CAT);
    for (int tile = gw; tile < 8 * (NTOK / 64); tile += NGW) { const int cb = tile & 7, tb = tile >> 3;
#pragma unroll 4
        for (int i = 0; i < 64; ++i) scr[i * 66 + lane] = BT[(size_t)(cb * 64 + i) * NTOK + tb * 64 + lane];
        asm volatile("s_waitcnt lgkmcnt(0)" ::: "memory");
#pragma unroll 4
        for (int j = 0; j < 64; ++j) CAT[(size_t)(tb * 64 + j) * 1024 + 512 + cb * 64 + lane] = scr[lane * 66 + j];
        asm volatile("s_waitcnt lgkmcnt(0)" ::: "memory");
    }
}
typedef short s16x4 __attribute__((ext_vector_type(4)));
__device__ __forceinline__ s16x4 tr16(const LAS bf16* p) { return __builtin_amdgcn_ds_read_tr16_b64_v4i16((LAS s16x4*)p); }
__device__ __forceinline__ int ret_tok0(int n, int dir, int b) { return n < 2 ? NLAT + b * CTXL + 128 * (dir ? 1 - n : n) : b * SEQ + 128 * (dir ? 33 - n : n - 2); }
__device__ __forceinline__ void phase_retscan(const KArgs& a, LAS unsigned char* lds, int o) {
    const int tid = TIDX(), wave = __builtin_amdgcn_readfirstlane(tid >> 6), lane = tid & 63, li = lane & 15, g = lane >> 4;
    constexpr int KP = 264, VP = 72, SP = 264;
    LAS bf16* KL = (LAS bf16*)lds; LAS bf16* VL = (LAS bf16*)(lds + 67584); LAS bf16* ST = (LAS bf16*)(lds + 67584 + 18432);
    const bf16* QKV = (const bf16*)(WSB(a) + WS_BIG + RT_QK); bf16* O = (bf16*)(WSB(a) + WS_BIG + RT_O);
    for (int task = BIDX(); task < 256; task += gridDim.x) {
        const int p = (task & 7) * 4 + (task >> 6), es = (task >> 3) & 7; const int b = p >> 2, hd = p & 3;
        for (int dir = 0; dir < 2; ++dir) {
            int tidd = tid; asm volatile("" : "+v"(tidd));
            const float logit = (dir ? AIN(a, 30) : AIN(a, 29))[o * 4 + hd];
            const float lg = fminf(logit, 0.f) - log1pf(expf(-fabsf(logit)));
            const float gch = expf(lg * 128.f);
            f32x4 st[2][4];
#pragma unroll
            for (int mt = 0; mt < 2; ++mt)
#pragma unroll
                for (int nt = 0; nt < 4; ++nt) st[mt][nt] = (f32x4){0.f, 0.f, 0.f, 0.f};
            for (int i = tidd; i < 64 * SP / 2; i += 512) ((LAS unsigned*)ST)[i] = 0u;
            const int lid = tidd & 15, gd = (tidd & 63) >> 4; const int qt = wave < 4 ? wave : 11 - wave;
            const int iq = 16 * qt + lid;
            const float xi = expf(lg * (dir ? (float)(128 - iq) : (float)(iq + 1)));
            const float sgl = dir ? -lg : lg;
            const float cm0 = expf(sgl * (float)(iq - 4 * gd)), rm1 = expf(-sgl);
            const float hz0 = expf(lg * (dir ? (float)(8 * gd) : (float)(127 - 8 * gd))), rz1 = expf(dir ? lg : -lg);
            const float r16 = expf(-sgl * 16.f), r32 = expf(-sgl * 32.f);
            bf16x8 qf[8];
            {
                const int tok0 = ret_tok0(0, dir, b);
#pragma unroll
                for (int i = 0; i < 8; ++i) { const int pid = tidd + 512 * i, row = pid >> 5, c16 = pid & 31; *(LAS u32x4*)(KL + row * KP + 8 * c16) = *(const u32x4*)(QKV + (unsigned)((tok0 + row) * 4096 + 1024 + hd * 256 + 8 * c16)); }
#pragma unroll
                for (int i = 0; i < 2; ++i) { const int pid = tidd + 512 * i, row = pid >> 3, c16 = pid & 7; *(LAS u32x4*)(VL + row * VP + 8 * c16) = *(const u32x4*)(QKV + (unsigned)((tok0 + row) * 4096 + 2048 + hd * 512 + es * 64 + 8 * c16)); }
                const bf16* qp = QKV + (unsigned)((tok0 + iq) * 4096 + hd * 256 + 8 * gd);
#pragma unroll
                for (int ks = 0; ks < 8; ++ks) qf[ks] = *(const bf16x8*)(qp + 32 * ks);
            }
            __syncthreads();
            for (int n = 0; n < 34; ++n) {
                float lgc = lg; asm volatile("" : "+v"(lgc)); int lic = li; asm volatile("" : "+v"(lic)); int gc = g; asm volatile("" : "+v"(gc)); int tidc = tid; asm volatile("" : "+v"(tidc)); int wvc = wave; asm volatile("" : "+s"(wvc)); float cm0c = cm0; asm volatile("" : "+v"(cm0c)); float hz0c = hz0; asm volatile("" : "+v"(hz0c));
                int qtc = qt; asm volatile("" : "+s"(qtc)); const int iqc = 16 * qtc + lic;
                const int tok0 = ret_tok0(n, dir, b);
                const bool more = n + 1 < 34; const int tokn = more ? ret_tok0(n + 1, dir, b) : tok0;
                u32x4 kreg[8], vreg[2]; u32x2 oldo[4] = {};
#pragma unroll
                for (int i = 0; i < 8; ++i) { const int pid = tidc + 512 * i, row = pid >> 5, c16 = pid & 31; kreg[i] = *(const u32x4*)(QKV + (unsigned)((tokn + row) * 4096 + 1024 + hd * 256 + 8 * c16)); }
#pragma unroll
                for (int i = 0; i < 2; ++i) { const int pid = tidc + 512 * i, row = pid >> 3, c16 = pid & 7; vreg[i] = *(const u32x4*)(QKV + (unsigned)((tokn + row) * 4096 + 2048 + hd * 512 + es * 64 + 8 * c16)); }
                bf16* orow = O + (unsigned)((tok0 + iqc) * 2048 + hd * 512 + es * 64 + 4 * gc);
                union { u32x4 u; bf16x8 v; } pf[4];
                float btc = 1.f;
#pragma unroll
                for (int jt = 0; jt < 8; ++jt) {
                    f32x4 acc = {0.f, 0.f, 0.f, 0.f};
                    const bool need = dir ? (jt >= qtc) : (jt <= qtc);
                    if (need) { const LAS bf16* kp = KL + (16 * jt + lic) * KP + 8 * gc;
#pragma unroll
                        for (int ks = 0; ks < 8; ++ks) acc = mfma16(*(const LAS bf16x8*)(kp + 32 * ks), qf[ks], acc);
                        { float fm = cm0c * btc;
#pragma unroll
                        for (int j = 0; j < 4; ++j) { const int kj = 16 * jt + 4 * gc + j; const int df = dir ? kj - iqc : iqc - kj; acc[j] = df >= 0 ? acc[j] * fm : 0.f; fm *= rm1; } } }
                    btc *= r16;
                    __builtin_amdgcn_sched_barrier(0);
                    if (jt & 1) { pf[jt >> 1].u.z = pk2(acc[0], acc[1]); pf[jt >> 1].u.w = pk2(acc[2], acc[3]); } else { pf[jt >> 1].u.x = pk2(acc[0], acc[1]); pf[jt >> 1].u.y = pk2(acc[2], acc[3]); }
                }
                f32x4 o1[4];
#pragma unroll
                for (int et = 0; et < 4; ++et) o1[et] = (f32x4){0.f, 0.f, 0.f, 0.f};
#pragma unroll
                for (int ks = 0; ks < 8; ++ks) {
#pragma unroll
                    for (int et = 0; et < 4; ++et) { const bf16x8 sv = *(const LAS bf16x8*)(ST + (16 * et + lic) * SP + 32 * ks + 8 * gc); o1[et] = mfma16(sv, qf[ks], o1[et]); }
                    if (ks & 1) __builtin_amdgcn_sched_barrier(0); }
#pragma unroll
                for (int et = 0; et < 4; ++et) o1[et] = o1[et] * xi;
                __builtin_amdgcn_sched_barrier(0);
                { const bf16* qp = QKV + (unsigned)((tokn + iqc) * 4096 + hd * 256 + 8 * gc);
#pragma unroll
                  for (int ks = 0; ks < 8; ++ks) qf[ks] = *(const bf16x8*)(qp + 32 * ks); }
                if (dir) {
#pragma unroll
                    for (int et = 0; et < 4; ++et) oldo[et] = *(const u32x2*)(orow + 16 * et); }
                { const LAS bf16* vb = VL + (4 * gc + (lic >> 2)) * VP + 4 * (lic & 3);
#pragma unroll
                  for (int t2 = 0; t2 < 4; ++t2) {
#pragma unroll
                    for (int et = 0; et < 4; ++et) { const s16x4 r0 = tr16(vb + (32 * t2) * VP + 16 * et), r1 = tr16(vb + (32 * t2 + 16) * VP + 16 * et);
                        const bf16x8 va = __builtin_shufflevector(r0, r1, 0, 1, 2, 3, 4, 5, 6, 7); o1[et] = mfma16(va, pf[t2].v, o1[et]); }
                    __builtin_amdgcn_sched_barrier(0); } }
#pragma unroll
                for (int et = 0; et < 4; ++et) {
                    float r[4];
#pragma unroll
                    for (int j = 0; j < 4; ++j) r[j] = o1[et][j];
                    if (dir) { r[0] += bflo(oldo[et].x); r[1] += bfhi(oldo[et].x); r[2] += bflo(oldo[et].y); r[3] += bfhi(oldo[et].y); }
                    u32x2 w; w.x = pk2(r[0], r[1]); w.y = pk2(r[2], r[3]); *(u32x2*)(orow + 16 * et) = w; }
#pragma unroll
                for (int mt = 0; mt < 2; ++mt)
#pragma unroll
                    for (int nt = 0; nt < 4; ++nt) st[mt][nt] = st[mt][nt] * gch;
                float fks = 1.f;
                { const LAS bf16* kb = KL + (8 * gc + (lic >> 2)) * KP + 32 * wave + 4 * (lic & 3); const LAS bf16* vb = VL + (8 * gc + (lic >> 2)) * VP + 4 * (lic & 3);
#pragma unroll
                  for (int ks = 0; ks < 4; ++ks) {
                    float z[8];
                    { float zc = hz0c * fks;
#pragma unroll
                    for (int jj = 0; jj < 8; ++jj) { z[jj] = zc; zc *= rz1; } }
                    fks *= r32;
                    bf16x8 ka[2];
#pragma unroll
                    for (int mt = 0; mt < 2; ++mt) { const s16x4 r0 = tr16(kb + (32 * ks) * KP + 16 * mt), r1 = tr16(kb + (32 * ks + 4) * KP + 16 * mt);
                        union { u32x4 u; bf16x8 v; } kz;
                        kz.u.x = pk2(bf2f((unsigned short)r0[0]) * z[0], bf2f((unsigned short)r0[1]) * z[1]); kz.u.y = pk2(bf2f((unsigned short)r0[2]) * z[2], bf2f((unsigned short)r0[3]) * z[3]);
                        kz.u.z = pk2(bf2f((unsigned short)r1[0]) * z[4], bf2f((unsigned short)r1[1]) * z[5]); kz.u.w = pk2(bf2f((unsigned short)r1[2]) * z[6], bf2f((unsigned short)r1[3]) * z[7]);
                        ka[mt] = kz.v; }
#pragma unroll
                    for (int nt = 0; nt < 4; ++nt) { const s16x4 r0 = tr16(vb + (32 * ks) * VP + 16 * nt), r1 = tr16(vb + (32 * ks + 4) * VP + 16 * nt);
                        const bf16x8 vv = __builtin_shufflevector(r0, r1, 0, 1, 2, 3, 4, 5, 6, 7);
#pragma unroll
                        for (int mt = 0; mt < 2; ++mt) st[mt][nt] = mfma16(ka[mt], vv, st[mt][nt]); }
                    __builtin_amdgcn_sched_barrier(0);
                  } }
                __syncthreads();
#pragma unroll
                for (int mt = 0; mt < 2; ++mt)
#pragma unroll
                    for (int nt = 0; nt < 4; ++nt) { u32x2 w; w.x = pk2(st[mt][nt][0], st[mt][nt][1]); w.y = pk2(st[mt][nt][2], st[mt][nt][3]);
                        *(LAS u32x2*)(ST + (16 * nt + lic) * SP + 32 * wave + 16 * mt + 4 * gc) = w; }
                if (more) {
#pragma unroll
                    for (int i = 0; i < 8; ++i) { const int pid = tidc + 512 * i, row = pid >> 5, c16 = pid & 31; *(LAS u32x4*)(KL + row * KP + 8 * c16) = kreg[i]; }
#pragma unroll
                    for (int i = 0; i < 2; ++i) { const int pid = tidc + 512 * i, row = pid >> 3, c16 = pid & 7; *(LAS u32x4*)(VL + row * VP + 8 * c16) = vreg[i]; }
                }
                __syncthreads();
            }
        }
    }
}
__device__ __forceinline__ void phase_groupnorm(const KArgs& a, int nrows = NTOK) {
    const int wave = TIDX() >> 6, lane = TIDX() & 63; const int gw = BIDX() * 8 + wave, NGW = gridDim.x * 8;
    const bf16* O = (const bf16*)(WSB(a) + WS_BIG + RT_O); float* ST = (float*)(WSB(a) + WS_BIG + BIG_STATS);
    for (int row = gw; row < nrows; row += NGW) {
        const u32x4* p = (const u32x4*)(O + (size_t)row * 2048 + 32 * lane); u32x4 v[4]; float x[32];
#pragma unroll
        for (int q = 0; q < 4; ++q) { v[q] = p[q];
#pragma unroll
            for (int j = 0; j < 4; ++j) { x[8 * q + 2 * j] = bflo(v[q][j]); x[8 * q + 2 * j + 1] = bfhi(v[q][j]); } }
        float s = 0.f;
#pragma unroll
        for (int j = 0; j < 32; ++j) s += x[j];
        s += __shfl_xor(s, 1); s += __shfl_xor(s, 2); s += __shfl_xor(s, 4); s += __shfl_xor(s, 8);
        const float mu = s * (1.f / 512.f); float q2 = 0.f;
#pragma unroll
        for (int j = 0; j < 32; ++j) { const float d = x[j] - mu; q2 += d * d; }
        q2 += __shfl_xor(q2, 1); q2 += __shfl_xor(q2, 2); q2 += __shfl_xor(q2, 4); q2 += __shfl_xor(q2, 8);
        const float rstd = rsqrtf(q2 * (1.f / 512.f) + 1e-6f);
        if ((lane & 15) == 0) { ST[(size_t)row * 8 + (lane >> 4) * 2] = mu; ST[(size_t)row * 8 + (lane >> 4) * 2 + 1] = rstd; }
    }
}
#define RLX_AGENT __ATOMIC_RELAXED, __HIP_MEMORY_SCOPE_AGENT
#define XB_TMO      128
#define XB_XCNT(j)  (256  + 64 * (j))
#define XB_XSUB(j)  (1280 + 64 * (j))
#define XB_XGEN(j)  (2304 + 64 * (j))
#define XB_TOP      3328
#define XB_TOPGEN   3392
#define XCD_BAR_WORDS 3456
#define XB_SPIN_CAP (1u << 18)

__device__ __forceinline__ unsigned xb_ld(unsigned* p)              { return __hip_atomic_load(p, __ATOMIC_RELAXED, __HIP_MEMORY_SCOPE_AGENT); }
__device__ __forceinline__ unsigned xb_add(unsigned* p, unsigned v) { return __hip_atomic_fetch_add(p, v, __ATOMIC_RELAXED, __HIP_MEMORY_SCOPE_AGENT); }
__device__ __forceinline__ unsigned xb_xcc_id() { return (unsigned)__builtin_amdgcn_s_getreg((3 << 11) | 20) & 0xFu; }
#define XB_SPIN(cond, bar) do { unsigned _sp = 0; while (cond) { __builtin_amdgcn_s_sleep(1); \
    if ((++_sp & 255u) == 0u) { if (xb_ld(&(bar)[XB_TMO])) break; if (_sp > XB_SPIN_CAP) { atomicAdd(&(bar)[XB_TMO], 1u); break; } } } } while (0)

struct XcdBarrier {
    unsigned* bar; unsigned x;
    volatile LAS unsigned* st;
};

__device__ __forceinline__ XcdBarrier xcd_barrier_post(unsigned* bar, volatile LAS unsigned* st) {
    XcdBarrier b; b.bar = bar; b.x = xb_xcc_id(); b.st = st;
    if (threadIdx.x == 0) (void)xb_add(&bar[XB_XCNT(b.x)], 1u);
    return b;
}
__device__ __forceinline__ void xcd_barrier_complete(unsigned* bar, unsigned x, unsigned& nloc, unsigned& nx) {
    const unsigned G = gridDim.x * gridDim.y * gridDim.z;
    unsigned sum, cnt, mine, sp = 0u;
    for (;;) {
        sum = 0u; cnt = 0u; mine = 0u;
#pragma unroll
        for (unsigned j = 0; j < 16; ++j) { const unsigned c = xb_ld(&bar[XB_XCNT(j)]); sum += c; cnt += (c > 0u) ? 1u : 0u; mine = (j == x) ? c : mine; }
        if (sum == G) break;
        __builtin_amdgcn_s_sleep(1);
        if ((++sp & 255u) == 0u) { if (xb_ld(&bar[XB_TMO])) break; if (sp > XB_SPIN_CAP) { atomicAdd(&bar[XB_TMO], 1u); break; } }
    }
    nloc = mine > 0u ? mine : 1u; nx = cnt > 0u ? cnt : 1u;
}

__device__ __forceinline__ void xcd_barrier(const XcdBarrier& b) {
    asm volatile("s_waitcnt vmcnt(0)" ::: "memory");
    __syncthreads();
    if (threadIdx.x == 0) {
        unsigned* bar = b.bar;
        __builtin_amdgcn_s_waitcnt(0);
        unsigned nloc = b.st[0], nx = b.st[1];
        if (nloc == 0u) { xcd_barrier_complete(bar, b.x, nloc, nx); b.st[0] = nloc; b.st[1] = nx; }
        const unsigned old = xb_add(&bar[XB_XSUB(b.x)], 1u);
        const unsigned gen = old / nloc;
        if (old + 1u == (gen + 1u) * nloc) {
            __builtin_amdgcn_fence(__ATOMIC_RELEASE, "agent");
            asm volatile("s_waitcnt vmcnt(0)" ::: "memory");
            const unsigned og = xb_add(&bar[XB_TOP], 1u);
            const unsigned tg = og / nx;
            if (og + 1u == (tg + 1u) * nx) xb_add(&bar[XB_TOPGEN], 1u);
            else XB_SPIN(xb_ld(&bar[XB_TOPGEN]) == tg, bar);
            __builtin_amdgcn_fence(__ATOMIC_ACQUIRE, "agent");
            xb_add(&bar[XB_XGEN(b.x)], 1u);
            asm volatile("s_waitcnt vmcnt(0)" ::: "memory");
        } else {
            XB_SPIN(xb_ld(&bar[XB_XGEN(b.x)]) == gen, bar);
            __builtin_amdgcn_fence(__ATOMIC_ACQUIRE, "agent");
            asm volatile("s_waitcnt vmcnt(0)" ::: "memory");
        }
    }
    __syncthreads();
}

#ifndef MK_MULTI
#define MK_MULTI 0
#endif
constexpr int NPH = 47;
#define REP_RET 1
#define REP_HY 1
#define REP_ATT 1
#define REP_GIN 1
#define REP_NM 1
#define REP_KV 1
#define REP_WF 1
#define REP_PRO 1
#define REP_GN 1
#define REP_GOUT 1
#define REP_MIN 1
template <class Epi> __device__ __forceinline__ void run_gemm(LAS unsigned char* lds, const bf16* A, const bf16* Bt, int M, int N, int K, const Epi E, int tailRows = 0, const bf16* A2 = nullptr, const bf16* Bt2 = nullptr, int M2 = 0, int N2 = 0, int loff = 0, int imax = 1 << 30) {
    pg8::Gemm g{A, Bt, M, N, K, A2, Bt2}; pg8::StaticOrder S; S.init(M, N, (int)gridDim.x, BIDX(), K, tailRows, M2, N2, loff, imax);
    pg8::gemm_phase<Epi, pg8::StaticOrder, !(__is_same(Epi, EpiResid) || __is_same(Epi, EpiResidNorm)), true>(lds, g, S, E);
}
__global__ void __launch_bounds__(512, 2) fwd_kernel(KArgs a) {
    extern __shared__ __attribute__((aligned(16))) unsigned char lds_raw[];
    LAS unsigned char* lds = (LAS unsigned char*)lds_raw;
    cg::grid_group grid = cg::this_grid();
    if (threadIdx.x < 4) ((LAS unsigned*)(lds + LDS_BYTES - 16))[threadIdx.x] = 0u;
    __syncthreads();
    XcdBarrier xbar = xcd_barrier_post((unsigned*)(a.ws + 65536), (volatile LAS unsigned*)(lds + LDS_BYTES - 16));
    const int lo = a.ph_lo, hi = a.ph_hi < 47 ? a.ph_hi : 47;
#define WSL(off) (wsl + (off))
#define P_H ((bf16*)WSL(WS_H))
#define P_GB ((bf16*)WSL(WS_BIG + BIG_G))
#define P_XC ((float*)WSL(WS_XC))
#define P_TAB ((const float*)WSL(WS_TAB))
#define P_W(o) ((const bf16*)WSL(WS_W + (o)))
#define P_MODL ((const float*)WSL(WS_MOD) + (size_t)layer * 9 * NMODV)
    for (int ph = lo; ph < hi; ++ph) {
        size_t zoff = 0; asm volatile("" : "+s"(zoff)); unsigned char* wsl = a.ws + zoff;
        int layer = 0, step = -1;
        if (ph > 0) { const int q = ph - 1; if (q < 11) { layer = 0; step = q; } else if (q < 23) { layer = 1; step = q - 11; } else if (q < 34) { layer = 2; step = q - 23; } else { layer = 3; step = q - 34; } }
        const bool even = (layer & 1) == 0; const int e = layer >> 1;
        const int tail = even ? step - 8 : step - 9;
        if (step < 0) { for (int rr = 0; rr < REP_PRO; ++rr) phase_prologue(a, lds); }
        else if (step == 0) { for (int rr = 0; rr < REP_WF; ++rr) { phase_weights(a, lds, layer); if (even) phase_filter(a, e); } phase_normmod(a, layer, 0, NTOK, layer > 0, (layer > 0 && (int)gridDim.x == 256) ? NLAT : 0); }
        else if (step == 3 || tail == 0) {
            const bool fusedp = (int)gridDim.x == 256;
            if (fusedp && layer == 3 && step != 3) continue;
            phase_normmod(a, layer, step == 3 ? 1 : 2, (layer == 3 && step != 3) ? NLAT : NTOK, true, fusedp ? NLAT : 0); }
        else if (step == 1 || tail == 1) { for (int rr = 0; rr < REP_GIN; ++rr) run_gemm(lds, P_H, P_W(step == 1 ? W_AIN : W_BIN), (layer == 3 && step > 1) ? NLAT : NTOK, 2 * DFF, DM, EpiSwiGLU{P_GB}); }
        else if (step == 2 || tail == 2 || (even && step == 7) || (!even && step == 8)) {
            const bool ffn = (step == 2 || tail == 2);
            const bf16* A = ffn ? P_GB : (const bf16*)WSL(WS_BIG + (even ? EV_CAT : RT_O)); const bf16* Bt = ffn ? P_W(step == 2 ? W_AOUT : W_BOUT) : P_W(W_MOUT);
            const int K = ffn ? DFF : (even ? DM : 2048); const int kmod = step == 2 ? 2 : (ffn ? 8 : 5);
            const bool noctx = (layer == 3) && step >= 8;
            const int nsub = step == 2 ? 1 : (ffn ? 0 : 2); const int nlayer = (ffn && step != 2) ? layer + 1 : layer;
            const float* xin = (layer == 0 && step == 2) ? a.in[0] : (const float*)a.out;
            if (nlayer < 4 && (int)gridDim.x == 256) {
                for (int hh = 0; hh < 2; ++hh) { const int bank = (layer * 3 + (step == 2 ? 0 : (ffn ? 2 : 1))) * 2 + hh;
                    pg8::Gemm g{A, Bt, NLAT, DM, K, nullptr, nullptr}; pg8::FusedOrder S; S.init(NLAT, DM, 256, BIDX(), K, (hh == 0 && !noctx) ? NCTX : 0, hh);
                    pg8::gemm_phase<EpiResidNorm, pg8::FusedOrder, false, true>(lds, g, S, EpiResidNorm{a.out, wsl, xin, kmod | (nsub << 4) | (nlayer << 6) | (layer << 9) | (bank << 12) | ((ffn ? 1 : 0) << 20)}); }
            } else
            run_gemm(lds, A, Bt, NLAT, DM, K, EpiResid{a.out, wsl, xin, layer * 9 * NMODV + kmod * DM, ffn ? 0.5f : 1.0f}, noctx ? 0 : NCTX);
        }
        else if (even && step == 4) {
            for (int rr = 0; rr < REP_MIN; ++rr) run_gemm(lds, P_H, P_W(W_MIN), NTOK, 1024, DM, EpiBf16{(bf16*)WSL(WS_BIG + EV_QK), (size_t)1024, (bf16*)WSL(WS_BIG + EV_UT), (size_t)NTOK}, 0, P_W(W_MIN) + (size_t)1024 * DM, P_H, 2048, NTOK);
        }
        else if (even && step == 5) { for (int rr = 0; rr < REP_HY; ++rr) phase_hyena(a, lds, e); phase_qknorm(a, e); }
        else if (even && step == 6) { for (int rr = 0; rr < REP_ATT; ++rr) phase_attn(a, lds, e); phase_bt_transpose(a, lds); }
        else if (!even && step == 4) for (int rr = 0; rr < REP_MIN; ++rr) run_gemm(lds, P_H, P_W(W_MIN), NTOK, 4096, DM, EpiRopeN{(bf16*)WSL(WS_BIG + RT_QK), P_TAB});
        else if (!even && step == 5) { for (int rr = 0; rr < REP_RET; ++rr) phase_retscan(a, lds, e); }
        else if (!even && step == 6) phase_groupnorm(a, layer == 3 ? NLAT : NTOK);
        else if (!even && step == 7) run_gemm(lds, P_H, P_W(W_MIN) + (size_t)4096 * DM, layer == 3 ? NLAT : NTOK, 2048, DM, EpiGate{(bf16*)WSL(WS_BIG + RT_O), (const float*)WSL(WS_BIG + BIG_STATS)});
        if (ph + 1 < hi) { if (ph == 0) grid.sync(); else xcd_barrier(xbar); }
    }
}

extern "C" void kernel_launch(void* const* d_in, const int* in_sizes, int n_in, void* d_out, int out_size, void* d_ws, size_t ws_size, hipStream_t stream) {
    static int grid = 0;
    if (grid == 0) {
        if (n_in != 31 || out_size != NLAT * DM || ws_size < WS_NEED) { fprintf(stderr, "kernel_launch: unexpected shapes / workspace (n_in %d out %d ws %zu need %zu)\n", n_in, out_size, ws_size, (size_t)WS_NEED); grid = -1; return; }
        int dev = 0, cus = 0, per_cu = 0;
        (void)hipGetDevice(&dev); (void)hipDeviceGetAttribute(&cus, hipDeviceAttributeMultiprocessorCount, dev);
        if (hipFuncSetAttribute((const void*)fwd_kernel, hipFuncAttributeMaxDynamicSharedMemorySize, LDS_BYTES) != hipSuccess) { fprintf(stderr, "kernel_launch: hipFuncSetAttribute failed\n"); grid = -1; return; }
        if (hipOccupancyMaxActiveBlocksPerMultiprocessor(&per_cu, (const void*)fwd_kernel, 512, LDS_BYTES) != hipSuccess || per_cu < 1) { fprintf(stderr, "kernel_launch: occupancy query says %d\n", per_cu); per_cu = 1; }
        (void)hipGetLastError();
        grid = cus * per_cu;
    }
    if (grid < 0) return;
    (void)hipMemsetAsync((unsigned char*)d_ws + 65536, 0, 262144, stream);
    KArgs a{};
    for (int i = 0; i < 31; ++i) a.in[i] = (const float*)d_in[i];
    a.out = (float*)d_out; a.ws = (unsigned char*)d_ws;
#if MK_MULTI
    for (int p = 0; p < NPH; ++p) { a.ph_lo = p; a.ph_hi = p + 1; hipLaunchKernelGGL(fwd_kernel, dim3(grid), dim3(512), LDS_BYTES, stream, a); }
#else
    a.ph_lo = 0; a.ph_hi = NPH;
    void* args[] = {&a};
    hipError_t e = hipLaunchCooperativeKernel((const void*)fwd_kernel, dim3(grid), dim3(512), args, LDS_BYTES, stream);
    if (e != hipSuccess) fprintf(stderr, "cooperative launch failed: %s (grid %d)\n", hipGetErrorString(e), grid);
#endif
}
```

```cpp
#include <hip/hip_runtime.h>
#include <hip/hip_cooperative_groups.h>
#include <cstdio>
#include <cstdint>
namespace cg = cooperative_groups;
namespace pg8 {
#define PG8_LAS __attribute__((address_space(3)))
typedef unsigned short bf16_t;
typedef short bf16x8 __attribute__((ext_vector_type(8)));
typedef float f32x4 __attribute__((ext_vector_type(4)));
typedef unsigned u32x4 __attribute__((ext_vector_type(4)));
constexpr int BM = 256, BK = 64, HALF = 128, HTB = HALF * BK * 2  , STAGE_BYTES = 8 * HTB, NXCD = 8, WGM = 8;

__host__ __device__ __forceinline__ int lds_byte(int r, int c) { const int st = (r >> 4) * 2 + (c >> 5), rr = r & 15, cc = c & 31, ob = rr * 64 + cc * 2; return st * 1024 + (ob ^ (((ob >> 9) & 1) << 5)); }
__host__ __device__ __forceinline__ void stage_rc(int b, int& R, int& C) { const int st = b / 1024, sb = b % 1024, swz = sb ^ (((sb >> 9) & 1) << 5); R = (st >> 1) * 16 + swz / 64; C = (st & 1) * 32 + (swz % 64) / 2; }
__host__ __device__ __forceinline__ int perm32(int rho) { const int n = rho >> 4, i = rho & 15; return 8 * (i >> 2) + 4 * n + (i & 3); }

struct Unit { int pm, pn, k0, nt, split, which; };
struct Gemm { const bf16_t* A; const bf16_t* Bt; int M, N, K; const bf16_t* A2; const bf16_t* Bt2; };

struct StaticOrder {
    int nM, nN, nwg, G, c, ntK, tailM, nM2, nN2, nwg2;
    __host__ __device__ void init(int M, int N, int G_, int c_, int K = 1024, int tailRows = 0, int M2 = 0, int N2 = 0) { nM = M / BM; nN = N / BM; nwg = nM * nN; G = G_; c = c_; ntK = K / BK; tailM = tailRows / BM; nM2 = M2 / BM; nN2 = N2 / BM; nwg2 = nM2 * nN2; }
    __host__ __device__ static void tile_of(int wgid, int nM_, int nN_, int nwg_, int& pm, int& pn) {
        { const int q = nwg_ / NXCD, r = nwg_ % NXCD, xcd = wgid % NXCD, off = wgid / NXCD; wgid = (xcd < r ? xcd * (q + 1) : r * (q + 1) + (xcd - r) * q) + off; }
        const int nig = WGM * nN_, gid = wgid / nig, fm = gid * WGM, gsz = (nM_ - fm) < WGM ? (nM_ - fm) : WGM;
        pm = fm + ((wgid % nig) % gsz); pn = (wgid % nig) / gsz;
    }
    __host__ __device__ bool next(int i, Unit& u) const {
        const long L = (long)i * G + c;
        u.which = 0;
        if (L >= nwg) {
            if (nwg2) { const long l2 = L - nwg; if (l2 >= nwg2) return false; tile_of((int)l2, nM2, nN2, nwg2, u.pm, u.pn); u.k0 = 0; u.nt = ntK; u.split = 0; u.which = 1; return true; }
            const long idx = L - nwg; if (idx >= (long)tailM * nN * 4) return false;
            const int tile = (int)(idx >> 2), sp = (int)(idx & 3); u.pm = nM + tile / nN; u.pn = tile % nN;
            const int h = ntK >> 1, hb = h >> 2, hr = h & 3;
            const int p0 = sp * hb + (sp < hr ? sp : hr), pc = hb + (sp < hr ? 1 : 0);
            u.k0 = 2 * p0; u.nt = 2 * pc; u.split = sp + 1; return true;
        }
        tile_of((int)L, nM, nN, nwg, u.pm, u.pn); u.k0 = 0; u.nt = ntK; u.split = 0; return true;
    }
    __device__ __forceinline__ void a_ready(const Unit&) const {}
    __device__ __forceinline__ void done(const Unit&) const {}
};

__device__ __forceinline__ unsigned cvt_pk_bf16(float lo, float hi) { unsigned r; asm volatile("v_cvt_pk_bf16_f32 %0, %1, %2" : "=v"(r) : "v"(lo), "v"(hi)); return r; }
typedef float f32x2 __attribute__((ext_vector_type(2)));
template <class Epi, class Sched, bool ALIGN_EPI = false, bool SP2 = false>
__device__ __forceinline__ void gemm_phase(PG8_LAS unsigned char* lds, const Gemm g, const Sched& S, const Epi& E) {
    int tid_l = threadIdx.x; asm volatile("" : "+v"(tid_l)); const int tid = tid_l, wid = __builtin_amdgcn_readfirstlane(tid >> 6), lane = tid & 63, wr = wid >> 2, wc = wid & 3, fr = lane & 15, fq = lane >> 4;
    const int K = g.K;
    unsigned voffA[2], voffB[2];
#pragma unroll
    for (int i = 0; i < 2; ++i) { int R, C; stage_rc(tid * 16 + i * 8192, R, C); const int Rb = Epi::PERM ? ((R & ~31) + perm32(R & 31)) : R;
        voffA[i] = (unsigned)(R * K + C) * 2u; voffB[i] = (unsigned)(Rb * K + C) * 2u; }
    const size_t kstep = (size_t)(BK * 2);
    const size_t hstep = (size_t)HALF * K * 2;
    const size_t tstep = 2 * hstep;
    const unsigned ldsw = (unsigned)wid * 1024u;
    const int aoff = lds_byte(wr * 64 + fr, fq * 8), boff = lds_byte(wc * 32 + fr, fq * 8);
#define PG8_SA(b, h) (((b) * 2 + (h)) * HTB)
#define PG8_SB(b, h) ((4 + (b) * 2 + (h)) * HTB)
#define PG8_STAGE(bufoff, gbase, voff) do { _Pragma("unroll") for (int _i = 0; _i < 2; ++_i) \
        __builtin_amdgcn_global_load_lds((const unsigned*)((const char*)(gbase) + (voff)[_i]), (PG8_LAS unsigned*)(lds + (bufoff) + ldsw + _i * 8192), 16, 0, 0); } while (0)
#define PG8_LDA(dst, b, h) do { _Pragma("unroll") for (int m = 0; m < 4; ++m) _Pragma("unroll") for (int k = 0; k < 2; ++k) dst[m][k] = *(const PG8_LAS bf16x8*)(lds + PG8_SA(b, h) + aoff + m * 2048 + k * 1024); } while (0)
#define PG8_LDB(dst, b, h) do { _Pragma("unroll") for (int n = 0; n < 2; ++n) _Pragma("unroll") for (int k = 0; k < 2; ++k) dst[n][k] = *(const PG8_LAS bf16x8*)(lds + PG8_SB(b, h) + boff + n * 2048 + k * 1024); } while (0)
#define PG8_MMA(ai, bj, At, Bt) do { __builtin_amdgcn_s_setprio(1); _Pragma("unroll") for (int m = 0; m < 4; ++m) _Pragma("unroll") for (int n = 0; n < 2; ++n) _Pragma("unroll") for (int k = 0; k < 2; ++k) \
        acc[ai][bj][m][n] = __builtin_amdgcn_mfma_f32_16x16x32_bf16(Bt[n][k], At[m][k], acc[ai][bj][m][n], 0, 0, 0); __builtin_amdgcn_s_setprio(0); } while (0)
#define PG8_WAIT_V(n) asm volatile("s_waitcnt vmcnt(" #n ")" ::: "memory")
#define PG8_WAIT_L(n) asm volatile("s_waitcnt lgkmcnt(" #n ")" ::: "memory")
#define PG8_BAR __builtin_amdgcn_s_barrier()
#define PG8_SCHED __builtin_amdgcn_sched_barrier(0)
    Unit cur, nxt; int ui = 0;
    if (!S.next(0, cur)) return;
    f32x4 acc[2][2][4][2];
#pragma unroll
    for (int a = 0; a < 2; ++a)
#pragma unroll
        for (int b = 0; b < 2; ++b)
#pragma unroll
            for (int m = 0; m < 4; ++m)
#pragma unroll
                for (int n = 0; n < 2; ++n) acc[a][b][m][n] = (f32x4){0.f, 0.f, 0.f, 0.f};
    bf16x8 At[4][2], B0[2][2], B1[2][2];
    const char* cA = (const char*)(cur.which ? g.A2 : g.A) + (size_t)cur.pm * tstep + (size_t)cur.k0 * kstep; const char* cB = (const char*)(cur.which ? g.Bt2 : g.Bt) + (size_t)cur.pn * tstep + (size_t)cur.k0 * kstep;
    S.a_ready(cur);
    if constexpr (SP2) {
        PG8_STAGE(PG8_SB(0, 0), cB, voffB); PG8_STAGE(PG8_SB(0, 1), cB + hstep, voffB); PG8_STAGE(PG8_SA(0, 0), cA, voffA); PG8_STAGE(PG8_SA(0, 1), cA + hstep, voffA);
        if (wr == 1) PG8_BAR;
        PG8_WAIT_V(2); PG8_BAR;
        PG8_STAGE(PG8_SB(1, 0), cB + kstep, voffB); PG8_STAGE(PG8_SA(1, 0), cA + kstep, voffA); PG8_STAGE(PG8_SB(1, 1), cB + hstep + kstep, voffB);
        PG8_WAIT_V(6); PG8_BAR;
    } else {
        PG8_STAGE(PG8_SB(0, 0), cB, voffB); PG8_STAGE(PG8_SA(0, 0), cA, voffA); PG8_STAGE(PG8_SB(0, 1), cB + hstep, voffB); PG8_STAGE(PG8_SA(0, 1), cA + hstep, voffA);
        if (wr == 1) PG8_BAR;
        PG8_WAIT_V(4); PG8_BAR;
        PG8_STAGE(PG8_SB(1, 0), cB + kstep, voffB); PG8_STAGE(PG8_SA(1, 0), cA + kstep, voffA); PG8_STAGE(PG8_SB(1, 1), cB + hstep + kstep, voffB);
        PG8_WAIT_V(6); PG8_BAR;
    }
    for (;;) {
        const bool has_next = S.next(ui + 1, nxt);
        const char* nA = has_next ? (const char*)(nxt.which ? g.A2 : g.A) + (size_t)nxt.pm * tstep + (size_t)nxt.k0 * kstep : cA; const char* nB = has_next ? (const char*)(nxt.which ? g.Bt2 : g.Bt) + (size_t)nxt.pn * tstep + (size_t)nxt.k0 * kstep : cB;
        const int nt = cur.nt;
        for (int t = 0; t < nt; t += 2) {
            const bool last = (t == nt - 2);
            const char* a1 = cA + (size_t)(t + 1) * kstep;
            const char* a2 = last ? nA : cA + (size_t)(t + 2) * kstep; const char* b2 = last ? nB : cB + (size_t)(t + 2) * kstep;
            const char* a3 = a2 + kstep; const char* b3 = b2 + kstep;
            if (last && has_next) S.a_ready(nxt);
            if constexpr (SP2) {
            PG8_LDB(B0, 0, 0); PG8_LDB(B1, 0, 1); PG8_SCHED; PG8_LDA(At, 0, 0); PG8_STAGE(PG8_SA(1, 1), a1 + hstep, voffA);
            PG8_WAIT_V(8); PG8_WAIT_L(0); PG8_BAR; PG8_MMA(0, 0, At, B0); PG8_MMA(0, 1, At, B1); PG8_BAR; PG8_SCHED;
            PG8_LDA(At, 0, 1); PG8_STAGE(PG8_SB(0, 0), b2, voffB); PG8_STAGE(PG8_SB(0, 1), b2 + hstep, voffB); PG8_STAGE(PG8_SA(0, 0), a2, voffA);
            PG8_WAIT_V(8); PG8_WAIT_L(0); PG8_BAR; PG8_MMA(1, 0, At, B0); PG8_MMA(1, 1, At, B1); PG8_BAR; PG8_SCHED;
            PG8_LDB(B0, 1, 0); PG8_LDB(B1, 1, 1); PG8_SCHED; PG8_LDA(At, 1, 0); PG8_STAGE(PG8_SA(0, 1), a2 + hstep, voffA);
            PG8_WAIT_V(8); PG8_WAIT_L(0); PG8_BAR; PG8_MMA(0, 0, At, B0); PG8_MMA(0, 1, At, B1); PG8_BAR; PG8_SCHED;
            PG8_LDA(At, 1, 1); PG8_STAGE(PG8_SB(1, 0), b3, voffB); PG8_STAGE(PG8_SB(1, 1), b3 + hstep, voffB); PG8_STAGE(PG8_SA(1, 0), a3, voffA);
            PG8_WAIT_V(8); PG8_WAIT_L(0); PG8_BAR; PG8_MMA(1, 0, At, B0); PG8_MMA(1, 1, At, B1); PG8_BAR; PG8_SCHED;
            } else {
            PG8_LDB(B0, 0, 0); PG8_SCHED; PG8_LDA(At, 0, 0); PG8_STAGE(PG8_SA(1, 1), a1 + hstep, voffA);
            PG8_WAIT_L(8); PG8_BAR; PG8_WAIT_L(0); PG8_MMA(0, 0, At, B0); PG8_BAR; PG8_SCHED;
            PG8_LDB(B1, 0, 1); PG8_STAGE(PG8_SB(0, 0), b2, voffB);
            PG8_BAR; PG8_WAIT_L(0); PG8_MMA(0, 1, At, B1); PG8_BAR;
            PG8_LDA(At, 0, 1); PG8_STAGE(PG8_SA(0, 0), a2, voffA);
            PG8_BAR; PG8_WAIT_L(0); PG8_MMA(1, 0, At, B0); PG8_BAR; PG8_SCHED;
            PG8_STAGE(PG8_SB(0, 1), b2 + hstep, voffB);
            PG8_WAIT_V(6); PG8_BAR; PG8_MMA(1, 1, At, B1); PG8_BAR;
            PG8_LDB(B0, 1, 0); PG8_SCHED; PG8_LDA(At, 1, 0); PG8_STAGE(PG8_SA(0, 1), a2 + hstep, voffA);
            PG8_WAIT_L(8); PG8_BAR; PG8_WAIT_L(0); PG8_MMA(0, 0, At, B0); PG8_BAR; PG8_SCHED;
            PG8_LDB(B1, 1, 1); PG8_STAGE(PG8_SB(1, 0), b3, voffB);
            PG8_BAR; PG8_WAIT_L(0); PG8_MMA(0, 1, At, B1); PG8_BAR;
            PG8_LDA(At, 1, 1); PG8_STAGE(PG8_SA(1, 0), a3, voffA);
            PG8_BAR; PG8_WAIT_L(0); PG8_MMA(1, 0, At, B0); PG8_BAR; PG8_SCHED;
            PG8_STAGE(PG8_SB(1, 1), b3 + hstep, voffB);
            PG8_WAIT_V(6); PG8_BAR; PG8_MMA(1, 1, At, B1); PG8_BAR;
            }
        }
        if constexpr (ALIGN_EPI) { if (wr == 0) PG8_BAR; }
        if constexpr (!Epi::AFTER_DRAIN) { E(acc, cur, wr, wc, fr, fq); S.done(cur); }
        if (!has_next) break;
#pragma unroll
        for (int a = 0; a < 2; ++a)
#pragma unroll
            for (int b = 0; b < 2; ++b)
#pragma unroll
                for (int m = 0; m < 4; ++m)
#pragma unroll
                    for (int n = 0; n < 2; ++n) acc[a][b][m][n] = (f32x4){0.f, 0.f, 0.f, 0.f};
        cur = nxt; cA = nA; cB = nB; ++ui;
        if constexpr (ALIGN_EPI) { if (wr == 1) PG8_BAR; }
    }
    PG8_WAIT_V(0);
    if constexpr (!ALIGN_EPI) { if (wr == 0) PG8_BAR; }
    PG8_BAR;
    if constexpr (Epi::AFTER_DRAIN) { E.fused(acc, cur, wr, wc, fr, fq, lds, wid, lane); S.done(cur); }
#undef PG8_SA
#undef PG8_SB
#undef PG8_STAGE
#undef PG8_LDA
#undef PG8_LDB
#undef PG8_MMA
#undef PG8_WAIT_V
#undef PG8_WAIT_L
#undef PG8_BAR
#undef PG8_SCHED
}
}
constexpr int DM = 1024, NBATCH = 8, SEQ = 4096, CTXL = 256, NLAT = NBATCH * SEQ, NCTX = NBATCH * CTXL, NTOK = NLAT + NCTX, DFF = 2816;
constexpr int NMODV = 9 * DM;
constexpr size_t MiB = 1u << 20;
constexpr size_t WS_TAB = 0;
constexpr size_t WS_MOD = 1 * MiB;
constexpr size_t WS_GIL = 3 * MiB;
constexpr size_t WS_GIC = 3 * MiB + 8404992;
constexpr size_t WS_XC = 12 * MiB;
constexpr size_t WS_H = 20 * MiB;
constexpr size_t WS_W = 88 * MiB;
constexpr size_t W_AIN = 0, W_AOUT = 11 * MiB, W_BIN = W_AOUT + 5632 * 1024, W_BOUT = W_BIN + 11 * MiB, W_MIN = 33 * MiB, W_MOUT = 45 * MiB;
constexpr size_t WS_BIG = 137 * MiB;
constexpr size_t BIG_G = 0;
constexpr size_t EV_QK = 0, EV_UT = 68 * MiB, EV_BT = 204 * MiB, EV_CAT = 238 * MiB;
constexpr size_t RT_QK = 0, RT_O = 272 * MiB;
constexpr size_t BIG_STATS = 440 * MiB;
constexpr size_t BIG_PART = 408 * MiB;
constexpr size_t WS_NEED = WS_BIG + 472 * MiB;
constexpr int GIL_P = 2 * SEQ + 16, GIC_P = 2 * CTXL + 16;
constexpr int LDS_BYTES = 147456;

typedef unsigned short bf16;
typedef unsigned short bf16_t;
typedef short bf16x8 __attribute__((ext_vector_type(8)));
typedef float f32x4 __attribute__((ext_vector_type(4)));
typedef unsigned u32x4 __attribute__((ext_vector_type(4)));
typedef unsigned u32x2 __attribute__((ext_vector_type(2)));
#define LAS __attribute__((address_space(3)))

__device__ __forceinline__ unsigned f2bf(float f) { unsigned u = __builtin_bit_cast(unsigned, f); return (u + 0x7fffu + ((u >> 16) & 1u)) >> 16; }
__device__ __forceinline__ unsigned pk2(float lo, float hi) { unsigned r; asm("v_cvt_pk_bf16_f32 %0, %1, %2" : "=v"(r) : "v"(lo), "v"(hi)); return r; }
__device__ __forceinline__ float bflo(unsigned w) { return __builtin_bit_cast(float, w << 16); }
__device__ __forceinline__ float bfhi(unsigned w) { return __builtin_bit_cast(float, w & 0xffff0000u); }
__device__ __forceinline__ float bf2f(unsigned short h) { return __builtin_bit_cast(float, ((unsigned)h) << 16); }
__device__ __forceinline__ float siluf(float a) { return a * __builtin_amdgcn_rcpf(1.f + __expf(-a)); }
__device__ __forceinline__ f32x4 mfma16(bf16x8 a, bf16x8 b, f32x4 c) { return __builtin_amdgcn_mfma_f32_16x16x32_bf16(a, b, c, 0, 0, 0); }

__device__ __forceinline__ int TIDX() { int t = threadIdx.x; asm volatile("" : "+v"(t)); return t; }
__device__ __forceinline__ int BIDX() { int t = blockIdx.x; asm volatile("" : "+s"(t)); return t; }
struct KArgs { const float* in[31]; float* out; unsigned char* ws; int ph_lo, ph_hi; };
__device__ __forceinline__ unsigned char* WSB(const KArgs& a) { size_t z = 0; asm volatile("" : "+s"(z)); return a.ws + z; }

using pg8::Unit;
struct EpiBf16 {
    static constexpr bool PERM = false, AFTER_DRAIN = false;
    bf16* O; size_t ldc; bf16* O2; size_t ldc2;
    __device__ __forceinline__ void operator()(const f32x4 (&acc)[2][2][4][2], const Unit& u, int wr, int wc, int fr_, int fq_) const {
        int fr = fr_, fq = fq_; asm volatile("" : "+v"(fr), "+v"(fq));
#pragma unroll
        for (int ai = 0; ai < 2; ++ai)
#pragma unroll
            for (int m = 0; m < 4; ++m) { const size_t row = (size_t)u.pm * 256 + ai * 128 + wr * 64 + m * 16 + fr; bf16* Ob = u.which ? O2 : O; const size_t ld = u.which ? ldc2 : ldc;
#pragma unroll
                for (int bj = 0; bj < 2; ++bj)
#pragma unroll
                    for (int n = 0; n < 2; ++n) { const int col = u.pn * 256 + bj * 128 + wc * 32 + 16 * n + 4 * fq; const f32x4 v = acc[ai][bj][m][n];
                        u32x2 w; w.x = pk2(v[0], v[1]); w.y = pk2(v[2], v[3]); *(u32x2*)(Ob + row * ld + col) = w; } }
    }
};
struct EpiSwiGLU {
    static constexpr bool PERM = false, AFTER_DRAIN = false;
    bf16* G;
    __device__ __forceinline__ void operator()(const f32x4 (&acc)[2][2][4][2], const Unit& u, int wr, int wc, int fr_, int fq_) const {
        int fr = fr_, fq = fq_; asm volatile("" : "+v"(fr), "+v"(fq));
        const int hcol = u.pn * 128 + wc * 32 + 8 * fq;
#pragma unroll
        for (int ai = 0; ai < 2; ++ai)
#pragma unroll
            for (int m = 0; m < 4; ++m) { const size_t row = (size_t)u.pm * 256 + ai * 128 + wr * 64 + m * 16 + fr;
                const f32x4 a0 = acc[ai][0][m][0], b0 = acc[ai][0][m][1], a1 = acc[ai][1][m][0], b1 = acc[ai][1][m][1];
                u32x4 w; w.x = pk2(siluf(a0[0]) * b0[0], siluf(a0[1]) * b0[1]); w.y = pk2(siluf(a0[2]) * b0[2], siluf(a0[3]) * b0[3]);
                w.z = pk2(siluf(a1[0]) * b1[0], siluf(a1[1]) * b1[1]); w.w = pk2(siluf(a1[2]) * b1[2], siluf(a1[3]) * b1[3]);
                *(u32x4*)(G + row * DFF + hcol) = w; }
    }
};
struct EpiResid {
    static constexpr bool PERM = false, AFTER_DRAIN = false;
    float* xl; unsigned char* wsb; const float* xin; int moff; float coef;
    __device__ __forceinline__ void operator()(const f32x4 (&acc)[2][2][4][2], const Unit& u, int wr, int wc, int fr_, int fq_) const {
        int fr = fr_, fq = fq_; asm volatile("" : "+v"(fr), "+v"(fq));
        float* xc = (float*)(wsb + WS_XC); const float* modv = (const float*)(wsb + WS_MOD) + moff;
        const int row0 = u.pm * 256; const int bidx = row0 < NLAT ? (row0 >> 12) : 8;
        float* xb = row0 < NLAT ? xl + (size_t)row0 * DM : xc + (size_t)(row0 - NLAT) * DM; const float* xrd = row0 < NLAT ? xin + (size_t)row0 * DM : xb; const float* mv = modv + (size_t)bidx * NMODV;
        if (u.split) {
            float* pb = (float*)((unsigned char*)xc + (WS_BIG + BIG_PART - WS_XC)) + ((size_t)(u.split - 1) * NCTX + (row0 - NLAT)) * DM;
#pragma unroll
            for (int bj = 0; bj < 2; ++bj)
#pragma unroll
                for (int n = 0; n < 2; ++n) { const int col = u.pn * 256 + bj * 128 + wc * 32 + 16 * n + 4 * fq; const f32x4 g = *(const f32x4*)(mv + col) * coef;
#pragma unroll
                    for (int ai = 0; ai < 2; ++ai)
#pragma unroll
                        for (int m = 0; m < 4; ++m) *(f32x4*)(pb + (unsigned)((ai * 128 + wr * 64 + m * 16 + fr) * DM + col)) = g * acc[ai][bj][m][n]; }
            return;
        }
#pragma unroll
        for (int bj = 0; bj < 2; ++bj)
#pragma unroll
            for (int n = 0; n < 2; ++n) { const int col = u.pn * 256 + bj * 128 + wc * 32 + 16 * n + 4 * fq; const f32x4 g = *(const f32x4*)(mv + col) * coef;
#pragma unroll
                for (int ai = 0; ai < 2; ++ai) {
                    f32x4 xv[4];
#pragma unroll
                    for (int m = 0; m < 4; ++m) xv[m] = *(const f32x4*)(xrd + (unsigned)((ai * 128 + wr * 64 + m * 16 + fr) * DM + col));
#pragma unroll
                    for (int m = 0; m < 4; ++m) { const f32x4 xn = xv[m] + g * acc[ai][bj][m][n]; const unsigned ro = (unsigned)((ai * 128 + wr * 64 + m * 16 + fr) * DM + col);
                        *(f32x4*)(xb + ro) = xn; } } }
    }
};
struct EpiRopeN {
    static constexpr bool PERM = false, AFTER_DRAIN = false;
    bf16* O; const float* tab;
    __device__ __forceinline__ void operator()(const f32x4 (&acc)[2][2][4][2], const Unit& u, int wr, int wc, int fr_, int fq_) const {
        int fr = fr_, fq = fq_; asm volatile("" : "+v"(fr), "+v"(fq));
        if (u.pn >= 8) {
#pragma unroll
            for (int ai = 0; ai < 2; ++ai)
#pragma unroll
                for (int m = 0; m < 4; ++m) { const size_t row = (size_t)u.pm * 256 + ai * 128 + wr * 64 + m * 16 + fr;
#pragma unroll
                    for (int bj = 0; bj < 2; ++bj)
#pragma unroll
                        for (int n = 0; n < 2; ++n) { const int col = u.pn * 256 + bj * 128 + wc * 32 + 16 * n + 4 * fq; const f32x4 v = acc[ai][bj][m][n];
                            u32x2 w; w.x = pk2(v[0], v[1]); w.y = pk2(v[2], v[3]); *(u32x2*)(O + row * 4096 + col) = w; } }
            return;
        }
#pragma unroll
        for (int bj = 0; bj < 2; ++bj) { const int cc0 = u.pn * 256 + bj * 128 + wc * 32; const int sect = cc0 >> 10, hd = (cc0 & 1023) >> 8, s = (cc0 & 255) >> 7, gi = (cc0 & 127) >> 5;
            const int fi = 16 * gi + 4 * fq; const int c1 = sect * 1024 + hd * 256 + s * 128 + fi; const float sc = sect ? 0.0625f : 1.0f;
#pragma unroll
            for (int ai = 0; ai < 2; ++ai)
#pragma unroll
                for (int m = 0; m < 4; ++m) { const int row = u.pm * 256 + ai * 128 + wr * 64 + m * 16 + fr;
                    f32x4 cs = {1.f, 1.f, 1.f, 1.f}, sn = {0.f, 0.f, 0.f, 0.f};
                    if (row < NLAT) { const int t = row & 4095; const int pos = s ? (t & 63) : (t >> 6); cs = *(const f32x4*)(tab + pos * 64 + fi); sn = *(const f32x4*)(tab + 4096 + pos * 64 + fi); }
                    const f32x4 x1 = acc[ai][bj][m][0] * sc, x2 = acc[ai][bj][m][1] * sc; const f32x4 o1 = x1 * cs - x2 * sn, o2 = x1 * sn + x2 * cs;
                    u32x2 w; w.x = pk2(o1[0], o1[1]); w.y = pk2(o1[2], o1[3]); *(u32x2*)(O + (size_t)row * 4096 + c1) = w;
                    w.x = pk2(o2[0], o2[1]); w.y = pk2(o2[2], o2[3]); *(u32x2*)(O + (size_t)row * 4096 + c1 + 64) = w; } }
    }
};
struct EpiRopeT {
    static constexpr bool PERM = false, AFTER_DRAIN = false;
    bf16* O; const float* tab;
    __device__ __forceinline__ void operator()(const f32x4 (&acc)[2][2][4][2], const Unit& u, int wr, int wc, int fr_, int fq_) const {
        int fr = fr_, fq = fq_; asm volatile("" : "+v"(fr), "+v"(fq));
        if (u.pm >= 4) {
#pragma unroll
            for (int ai = 0; ai < 2; ++ai)
#pragma unroll
                for (int m = 0; m < 4; ++m) { const size_t row = (size_t)u.pm * 256 + ai * 128 + wr * 64 + m * 16 + fr;
#pragma unroll
                    for (int bj = 0; bj < 2; ++bj)
#pragma unroll
                        for (int n = 0; n < 2; ++n) { const int col = u.pn * 256 + bj * 128 + wc * 32 + 16 * n + 4 * fq; const f32x4 v = acc[ai][bj][m][n];
                            u32x2 w; w.x = pk2(v[0], v[1]); w.y = pk2(v[2], v[3]); *(u32x2*)(O + row * NTOK + col) = w; } }
            return;
        }
#pragma unroll
        for (int ai = 0; ai < 2; ++ai)
#pragma unroll
            for (int mp = 0; mp < 2; ++mp) { const int rb = u.pm * 256 + ai * 128 + wr * 64 + 32 * mp; const int hd = rb >> 8, s = (rb & 255) >> 7, gi = (rb & 127) >> 5; const int fi = 16 * gi + fr;
                const size_t r1 = (size_t)(hd * 256 + s * 128 + fi);
#pragma unroll
                for (int bj = 0; bj < 2; ++bj)
#pragma unroll
                    for (int n = 0; n < 2; ++n) { const int col = u.pn * 256 + bj * 128 + wc * 32 + 16 * n + 4 * fq;
                        f32x4 cs = {1.f, 1.f, 1.f, 1.f}, sn = {0.f, 0.f, 0.f, 0.f};
                        if (col < NLAT) {
#pragma unroll
                            for (int j = 0; j < 4; ++j) { const int t = (col + j) & 4095; const int pos = s ? (t & 63) : (t >> 6); cs[j] = tab[pos * 64 + fi]; sn[j] = tab[4096 + pos * 64 + fi]; } }
                        const f32x4 x1 = acc[ai][bj][2 * mp][n] * 0.0625f, x2 = acc[ai][bj][2 * mp + 1][n] * 0.0625f; const f32x4 o1 = x1 * cs - x2 * sn, o2 = x1 * sn + x2 * cs;
                        u32x2 w; w.x = pk2(o1[0], o1[1]); w.y = pk2(o1[2], o1[3]); *(u32x2*)(O + r1 * NTOK + col) = w;
                        w.x = pk2(o2[0], o2[1]); w.y = pk2(o2[2], o2[3]); *(u32x2*)(O + (r1 + 64) * NTOK + col) = w; } }
    }
};
struct EpiGate {
    static constexpr bool PERM = false, AFTER_DRAIN = false;
    bf16* Y; const float* stats;
    __device__ __forceinline__ void operator()(const f32x4 (&acc)[2][2][4][2], const Unit& u, int wr, int wc, int fr_, int fq_) const {
        int fr = fr_, fq = fq_; asm volatile("" : "+v"(fr), "+v"(fq));
        const int head = u.pn >> 1;
#pragma unroll
        for (int ai = 0; ai < 2; ++ai)
#pragma unroll
            for (int m = 0; m < 4; ++m) { const size_t row = (size_t)u.pm * 256 + ai * 128 + wr * 64 + m * 16 + fr;
                const float mu = stats[row * 8 + head * 2], rs = stats[row * 8 + head * 2 + 1];
#pragma unroll
                for (int bj = 0; bj < 2; ++bj)
#pragma unroll
                    for (int n = 0; n < 2; ++n) { const int col = u.pn * 256 + bj * 128 + wc * 32 + 16 * n + 4 * fq; const f32x4 v = acc[ai][bj][m][n];
                        u32x2* p = (u32x2*)(Y + row * 2048 + col); const u32x2 y = *p;
                        u32x2 w; w.x = pk2(siluf(v[0]) * (bflo(y.x) - mu) * rs, siluf(v[1]) * (bfhi(y.x) - mu) * rs); w.y = pk2(siluf(v[2]) * (bflo(y.y) - mu) * rs, siluf(v[3]) * (bfhi(y.y) - mu) * rs); *p = w; } }
    }
};
__device__ __forceinline__ float wave_sum(float v) {
#pragma unroll
    for (int o = 1; o < 64; o <<= 1) v += __shfl_xor(v, o);
    return v;
}
template <int MAP> __device__ __forceinline__ int rowmap(int n) {
    if (MAP == 1) { const int sec = n >= DFF ? 1 : 0, hh = n - sec * DFF, hl = hh & 127; return 256 * (hh >> 7) + 128 * ((hl & 7) >> 2) + 32 * (hl >> 5) + 16 * sec + 4 * ((hl & 31) >> 3) + (hl & 3); }
    if (MAP == 2) { if (n >= 2048) return n; const int d = n & 255, qd = d >> 6, fi = d & 63; return (n - d) + (qd >> 1) * 128 + 32 * (fi >> 4) + 16 * (qd & 1) + (fi & 15); }
    return n;
}
template <int MAP> __device__ __forceinline__ void transpose_item(const float* W, int K, int N, bf16* WT, LAS float* scr, int item, int lane) {
    const int nblk = N / 32, kb = item / nblk, nb = item % nblk, k0 = 64 * kb, n0 = 32 * nb;
#pragma unroll 8
    for (int i = 0; i < 32; ++i) { const int kk = 2 * i + (lane >> 5); scr[kk * 33 + (lane & 31)] = W[(size_t)(k0 + kk) * N + n0 + (lane & 31)]; }
    asm volatile("s_waitcnt lgkmcnt(0)" ::: "memory");
    const int c = lane & 7;
#pragma unroll
    for (int j = 0; j < 4; ++j) { const int n = (lane >> 3) + 8 * j; const LAS float* s = scr + (8 * c) * 33 + n;
        u32x4 o; o.x = pk2(s[0 * 33], s[1 * 33]); o.y = pk2(s[2 * 33], s[3 * 33]); o.z = pk2(s[4 * 33], s[5 * 33]); o.w = pk2(s[6 * 33], s[7 * 33]);
        *(u32x4*)(WT + (size_t)rowmap<MAP>(n0 + n) * K + k0 + 8 * c) = o; }
    asm volatile("s_waitcnt lgkmcnt(0)" ::: "memory");
}

__device__ __forceinline__ void phase_prologue(const KArgs& a, LAS unsigned char* lds) {
    const int tid = TIDX(), G = gridDim.x, bid = BIDX();
    {
        const f32x4* cs = (const f32x4*)a.in[2]; f32x4* cd = (f32x4*)(WSB(a) + WS_XC);
        for (size_t i = (size_t)bid * 512 + tid; i < (size_t)NCTX * DM / 4; i += (size_t)G * 512) cd[i] = cs[i];
    }
    {
        float* tab = (float*)(WSB(a) + WS_TAB);
        for (int i = bid * 512 + tid; i < 4096; i += G * 512) { const int pos = i >> 6, f = i & 63; const float inv = powf(10000.f, -(float)f / 64.f); const float ang = (float)pos * inv; tab[i] = cosf(ang); tab[4096 + i] = sinf(ang); }
    }
    LAS float* sv = (LAS float*)lds;
    LAS float* red = (LAS float*)(lds + 36864);
    for (int i = tid; i < 9 * DM; i += 512) { const float v = i < 8 * DM ? a.in[1][i] : a.in[3][i - 8 * DM]; sv[i] = siluf(v); }
    __syncthreads();
    const int wave = tid >> 6, lane = tid & 63;
    float* MOD = (float*)(WSB(a) + WS_MOD);
    for (int item = bid; item < 4 * (NMODV / 64); item += G) {
        const int layer = item / (NMODV / 64), cb = item % (NMODV / 64); const int col = cb * 64 + lane;
        const float* W = a.in[4] + (size_t)layer * DM * NMODV + col;
        float acc[9];
#pragma unroll
        for (int r = 0; r < 9; ++r) acc[r] = 0.f;
#pragma unroll 4
        for (int kk = 0; kk < 128; ++kk) { const int k = wave * 128 + kk; const float w = W[(size_t)k * NMODV];
#pragma unroll
            for (int r = 0; r < 9; ++r) acc[r] += sv[r * DM + k] * w; }
#pragma unroll
        for (int r = 0; r < 9; ++r) red[(wave * 9 + r) * 64 + lane] = acc[r];
        __syncthreads();
        for (int o = tid; o < 9 * 64; o += 512) { const int r = o >> 6, l = o & 63; float s = 0.f;
#pragma unroll
            for (int w = 0; w < 8; ++w) s += red[(w * 9 + r) * 64 + l];
            MOD[((size_t)layer * 9 + r) * NMODV + cb * 64 + l] = s + a.in[5][(size_t)layer * NMODV + cb * 64 + l]; }
        __syncthreads();
    }
}

__device__ __forceinline__ void phase_weights(const KArgs& a, LAS unsigned char* lds, int layer) {
    const int wave = TIDX() >> 6, lane = TIDX() & 63; const int gw = BIDX() * 8 + wave, NGW = gridDim.x * 8;
    LAS float* scr = (LAS float*)(lds + wave * 16384);
    unsigned char* wb = WSB(a) + WS_W; const int e = layer >> 1;
    const int I_IN = 16 * (2 * DFF / 32), I_OUT = (DFF / 64) * 32;
    const bool even = (layer & 1) == 0;
    const int I_MI = even ? 16 * (3072 / 32) : 16 * (6144 / 32), I_MO = even ? 16 * 32 : 32 * 32;
    const int total = 2 * I_IN + 2 * I_OUT + I_MI + I_MO;
    for (int it = gw; it < total; it += NGW) {
        int r = it;
        if (r < I_IN) { transpose_item<1>(a.in[7] + (size_t)layer * DM * 2 * DFF, DM, 2 * DFF, (bf16*)(wb + W_AIN), scr, r, lane); continue; } r -= I_IN;
        if (r < I_IN) { transpose_item<1>(a.in[9] + (size_t)layer * DM * 2 * DFF, DM, 2 * DFF, (bf16*)(wb + W_BIN), scr, r, lane); continue; } r -= I_IN;
        if (r < I_OUT) { transpose_item<0>(a.in[8] + (size_t)layer * DFF * DM, DFF, DM, (bf16*)(wb + W_AOUT), scr, r, lane); continue; } r -= I_OUT;
        if (r < I_OUT) { transpose_item<0>(a.in[10] + (size_t)layer * DFF * DM, DFF, DM, (bf16*)(wb + W_BOUT), scr, r, lane); continue; } r -= I_OUT;
        if (even) {
            if (r < I_MI) { transpose_item<0>(a.in[11] + (size_t)e * DM * 3072, DM, 3072, (bf16*)(wb + W_MIN), scr, r, lane); continue; } r -= I_MI;
            transpose_item<0>(a.in[12] + (size_t)e * DM * DM, DM, DM, (bf16*)(wb + W_MOUT), scr, r, lane);
        } else {
            if (r < I_MI) { transpose_item<2>(a.in[27] + (size_t)e * DM * 6144, DM, 6144, (bf16*)(wb + W_MIN), scr, r, lane); continue; } r -= I_MI;
            transpose_item<0>(a.in[28] + (size_t)e * 2048 * DM, 2048, DM, (bf16*)(wb + W_MOUT), scr, r, lane);
        }
    }
}

template <int NR> __device__ __forceinline__ void normmod_rows(const KArgs& a, const float* gain, const float* MOD, bf16* H, int sub, int row0, int rstride, int nrows, int lane, bool pending, bool first = false) {
    f32x4 v[NR][4]; float s[NR];
#pragma unroll
    for (int rr = 0; rr < NR; ++rr) { const int row = row0 + rr * rstride;
        if (row < nrows) { const float* xr = row < NLAT ? (first ? a.in[0] : a.out) + (size_t)row * DM : (const float*)(WSB(a) + WS_XC) + (size_t)(row - NLAT) * DM;
#pragma unroll
            for (int j = 0; j < 4; ++j) v[rr][j] = *(const f32x4*)(xr + 256 * j + 4 * lane); }
        else {
#pragma unroll
            for (int j = 0; j < 4; ++j) v[rr][j] = (f32x4){0.f, 0.f, 0.f, 0.f}; } }
#pragma unroll
    for (int rr = 0; rr < NR; ++rr) { const int row = row0 + rr * rstride;
        if (row >= NLAT && row < nrows && pending) {
            const float* pp = (const float*)(WSB(a) + WS_BIG + BIG_PART) + (size_t)(row - NLAT) * DM + 4 * lane;
#pragma unroll
            for (int sp = 0; sp < 4; ++sp)
#pragma unroll
                for (int j = 0; j < 4; ++j) v[rr][j] += *(const f32x4*)(pp + (size_t)sp * NCTX * DM + 256 * j);
#pragma unroll
            for (int j = 0; j < 4; ++j) *(f32x4*)((float*)(WSB(a) + WS_XC) + (size_t)(row - NLAT) * DM + 256 * j + 4 * lane) = v[rr][j];
        }
        float q = 0.f;
#pragma unroll
        for (int j = 0; j < 4; ++j) q += (v[rr][j][0] * v[rr][j][0] + v[rr][j][1] * v[rr][j][1]) + (v[rr][j][2] * v[rr][j][2] + v[rr][j][3] * v[rr][j][3]);
        s[rr] = q; }
#pragma unroll
    for (int o = 1; o < 64; o <<= 1) {
#pragma unroll
        for (int rr = 0; rr < NR; ++rr) s[rr] += __shfl_xor(s[rr], o); }
#pragma unroll
    for (int j = 0; j < 4; ++j) { const int c = 256 * j + 4 * lane; const f32x4 g = *(const f32x4*)(gain + c);
#pragma unroll
        for (int rr = 0; rr < NR; ++rr) { const int row = row0 + rr * rstride;
            if (row < nrows) { const int bidx = row < NLAT ? (row >> 12) : 8; const float* sh = MOD + (size_t)bidx * NMODV + (3 * sub) * DM;
                const f32x4 sc = *(const f32x4*)(sh + DM + c), sf = *(const f32x4*)(sh + c); const float rstd = rsqrtf(s[rr] * (1.f / DM) + 1e-6f);
                const f32x4 o = v[rr][j] * rstd * g * (sc + 1.f) + sf; u32x2 w; w.x = pk2(o[0], o[1]); w.y = pk2(o[2], o[3]); *(u32x2*)(H + (size_t)row * DM + c) = w; } } }
}
__device__ __forceinline__ void phase_normmod(const KArgs& a, int layer, int sub, int nrows = NTOK, bool pending = true) {
    const int wave = TIDX() >> 6, lane = TIDX() & 63; const int gw = BIDX() * 8 + wave, NGW = gridDim.x * 8;
    const float* gain = a.in[6] + ((size_t)layer * 3 + sub) * DM; const float* MOD = (const float*)(WSB(a) + WS_MOD) + (size_t)layer * 9 * NMODV;
    bf16* H = (bf16*)(WSB(a) + WS_H);
    for (int row = gw; row < nrows; row += 4 * NGW) normmod_rows<4>(a, gain, MOD, H, sub, row, NGW, nrows, lane, pending, layer == 0 && sub == 0);
}

__device__ __forceinline__ void phase_filter(const KArgs& a, int e) {
    const int wave = TIDX() >> 6, lane = TIDX() & 63; const int gw = BIDX() * 8 + wave, NGW = gridDim.x * 8;
    const float* fw1 = a.in[18] + (size_t)e * 17 * 64; const float* fb1 = a.in[19] + e * 64; const float* fw2 = a.in[20] + (size_t)e * 4096; const float* fb2 = a.in[21] + e * 64;
    const float* fw3 = a.in[22] + (size_t)e * 4096; const float* fb3 = a.in[23] + e * 64; const float* fw4 = a.in[24] + (size_t)e * 64 * 1024; const float fr = a.in[25][e * 64 + lane];
    for (int p = gw; p < SEQ + CTXL; p += NGW) {
        const bool lat = p < SEQ; const int L = lat ? SEQ : CTXL, ti = lat ? p : p - SEQ; const int P = 2 * L + 16;
        bf16* GI = (bf16*)(WSB(a) + (lat ? WS_GIL : WS_GIC));
        const float tt = (float)ti / (float)(L - 1); const float w = 6.283185307179586f * (float)ti / (float)L;
        float h = tt * fw1[lane];
#pragma unroll
        for (int k = 0; k < 8; ++k) { const float band = 1e-4f + (float)k * ((7.0f - 1e-4f) / 7.0f); const float ang = band * w; h += cosf(ang) * fw1[(1 + k) * 64 + lane] - sinf(ang) * fw1[(9 + k) * 64 + lane]; }
        h = sinf(fr * (h + fb1[lane]));
        float h2 = fb2[lane];
        for (int k = 0; k < 64; ++k) h2 += __shfl(h, k) * fw2[k * 64 + lane];
        h2 = sinf(fr * h2);
        float h3 = fb3[lane];
        for (int k = 0; k < 64; ++k) h3 += __shfl(h2, k) * fw3[k * 64 + lane];
        h3 = sinf(fr * h3);
        float o[16];
#pragma unroll
        for (int j = 0; j < 16; ++j) o[j] = 0.f;
        for (int k = 0; k < 64; ++k) { const float hk = __shfl(h3, k);
#pragma unroll
            for (int j = 0; j < 16; ++j) o[j] += hk * fw4[k * 1024 + 64 * j + lane]; }
        const float maxd = -15.350567286626973f, mind = -3.0701134573253945f;
#pragma unroll
        for (int j = 0; j < 8; ++j) { const int c = 64 * j + lane; const float delta = mind + (float)c * ((maxd - mind) / 511.f); const float win = expf(-tt * fabsf(delta));
            const float hf = o[j] * win, hb = o[j + 8] * win; bf16* g = GI + (size_t)c * P;
            if (ti == 0) { g[L + 15] = (bf16)f2bf(hf + hb); for (int u = 0; u < 16; ++u) g[u] = 0; g[2 * L + 15] = 0; }
            else { g[L + 15 - ti] = (bf16)f2bf(hf); g[L + 15 + ti] = (bf16)f2bf(hb); } }
    }
}
__device__ __forceinline__ void phase_qknorm(const KArgs& a, int e) {
    const int wave = TIDX() >> 6, lane = TIDX() & 63; const int gw = BIDX() * 8 + wave, NGW = gridDim.x * 8;
    bf16* QK = (bf16*)(WSB(a) + WS_BIG + EV_QK);
    const int grp = lane >> 2; const float* gp = (grp < 8 ? a.in[13] : a.in[14]) + e * 64 + 16 * (lane & 3); const float extra = grp < 8 ? 0.125f : 1.0f;
    float g[16];
#pragma unroll
    for (int j = 0; j < 16; ++j) g[j] = gp[j] * extra;
    for (int row = gw; row < NTOK; row += NGW) {
        u32x4* p = (u32x4*)(QK + (size_t)row * 1024 + 16 * lane); u32x4 v0 = p[0], v1 = p[1];
        float x[16];
#pragma unroll
        for (int j = 0; j < 4; ++j) { x[2 * j] = bflo(v0[j]); x[2 * j + 1] = bfhi(v0[j]); x[8 + 2 * j] = bflo(v1[j]); x[9 + 2 * j] = bfhi(v1[j]); }
        float s = 0.f;
#pragma unroll
        for (int j = 0; j < 16; ++j) s += x[j] * x[j];
        s += __shfl_xor(s, 1); s += __shfl_xor(s, 2);
        const float rstd = rsqrtf(s * (1.f / 64.f) + 1e-6f);
#pragma unroll
        for (int j = 0; j < 4; ++j) { v0[j] = pk2(x[2 * j] * rstd * g[2 * j], x[2 * j + 1] * rstd * g[2 * j + 1]); v1[j] = pk2(x[8 + 2 * j] * rstd * g[8 + 2 * j], x[9 + 2 * j] * rstd * g[9 + 2 * j]); }
        p[0] = v0; p[1] = v1;
    }
}

template <bool WIN> __device__ __forceinline__ int attn_ktok(int t, int b, int rs, int kb, int ctok0) {
    if (WIN && t < 16) return b * SEQ + (rs + (t >> 1)) * 64 + kb + 4 * (t & 1);
    return ctok0 + 32 * ((WIN ? t - 16 : t) >> 1) + 4 * (t & 1);
}
template <bool WIN> __device__ __forceinline__ void attn_loadk(bf16x8 (&kf)[4][2], const bf16* QK, const LAS bf16* CK, int grp, int b, int h, int rs, int kb, int ctok0, int li, int g) {
    if (WIN && grp >= 4) {
#pragma unroll
        for (int q = 0; q < 4; ++q) { const int t = grp * 4 + q - 16; const LAS bf16* kp = CK + (32 * (t >> 1) + 4 * (t & 1) + 8 * (li >> 2) + (li & 3)) * 72 + 8 * g; kf[q][0] = *(const LAS bf16x8*)kp; kf[q][1] = *(const LAS bf16x8*)(kp + 32); }
        return;
    }
#pragma unroll
    for (int q = 0; q < 4; ++q) { const bf16* kp = QK + (unsigned)((attn_ktok<WIN>(grp * 4 + q, b, rs, kb, ctok0) + 8 * (li >> 2) + (li & 3)) * 1024 + 512 + h * 64 + 8 * g); kf[q][0] = *(const bf16x8*)kp; kf[q][1] = *(const bf16x8*)(kp + 32); }
}
template <bool WIN> __device__ __forceinline__ void attn_loadv(bf16x8 (&vf)[4], const bf16* VT, const LAS bf16* CV, int t2, int b, int h, int rs, int kb, int ctok0, int li, int g) {
    if (WIN && t2 >= 8) {
#pragma unroll
        for (int dt = 0; dt < 4; ++dt) vf[dt] = *(const LAS bf16x8*)(CV + (16 * dt + li) * 264 + 32 * (t2 - 8) + 8 * g);
        return;
    }
    const int tb = (WIN && t2 < 8) ? b * SEQ + (rs + t2) * 64 + kb : ctok0 + 32 * (WIN ? t2 - 8 : t2);
#pragma unroll
    for (int dt = 0; dt < 4; ++dt) vf[dt] = *(const bf16x8*)(VT + (unsigned)((h * 64 + 16 * dt + li) * NTOK + tb + 8 * g));
}
template <bool WIN> __device__ __forceinline__ void attn_wave(const bf16* QK, const bf16* VT, bf16* CAT, const LAS float* rpbL, const LAS bf16* CK, const LAS bf16* CV, int b, int h, int r, int c0, int qtok0, int lane) {
    const int li = lane & 15, g = lane >> 4;
    constexpr int NT = WIN ? 32 : 16, NG = NT / 4;
    bf16x8 qf[2];
    { const bf16* qp = QK + (unsigned)((qtok0 + li) * 1024 + h * 64 + 8 * g); qf[0] = *(const bf16x8*)qp; qf[1] = *(const bf16x8*)(qp + 32); }
    const int rs = WIN ? min(max(r - 4, 0), 56) : 0, kb = WIN ? min(max(c0 - 8, 0), 32) : 0;
    const int ctok0 = NLAT + b * CTXL;
    f32x4 sc[NT];
    bf16x8 kfa[4][2], kfb[4][2];
    attn_loadk<WIN>(kfa, QK, CK, 0, b, h, rs, kb, ctok0, li, g);
#pragma unroll
    for (int grp = 0; grp < NG; ++grp) {
        if (grp + 1 < NG) { if (grp & 1) attn_loadk<WIN>(kfa, QK, CK, grp + 1, b, h, rs, kb, ctok0, li, g); else attn_loadk<WIN>(kfb, QK, CK, grp + 1, b, h, rs, kb, ctok0, li, g); }
#pragma unroll
        for (int q = 0; q < 4; ++q) { const int t = grp * 4 + q;
            f32x4 acc = {0.f, 0.f, 0.f, 0.f};
            if (grp & 1) { acc = mfma16(kfb[q][0], qf[0], acc); acc = mfma16(kfb[q][1], qf[1], acc); } else { acc = mfma16(kfa[q][0], qf[0], acc); acc = mfma16(kfa[q][1], qf[1], acc); }
            if (WIN && t < 16) {
                const int qc = c0 + li, cs = min(max(qc - 8, 0), 48); const int dr = rs + (t >> 1) - r + 7;
#pragma unroll
                for (int j = 0; j < 4; ++j) { const int kc = kb + 8 * g + 4 * (t & 1) + j; const bool ok = kc >= cs && kc < cs + 16;
                    const int dc = min(max(kc - qc + 15, 0), 30); const float bias = rpbL[dr * 31 + dc]; acc[j] = ok ? acc[j] + bias : -1e30f; }
            }
            sc[t] = acc; }
        __builtin_amdgcn_sched_barrier(0);
    }
    bf16x8 vfa[4], vfb[4];
    attn_loadv<WIN>(vfa, VT, CV, 0, b, h, rs, kb, ctok0, li, g);
    attn_loadv<WIN>(vfb, VT, CV, 1, b, h, rs, kb, ctok0, li, g);
    float mx = -1e30f;
#pragma unroll
    for (int t = 0; t < NT; ++t) mx = fmaxf(mx, fmaxf(fmaxf(sc[t][0], sc[t][1]), fmaxf(sc[t][2], sc[t][3])));
    mx = fmaxf(mx, __shfl_xor(mx, 16)); mx = fmaxf(mx, __shfl_xor(mx, 32));
    float sum = 0.f;
#pragma unroll
    for (int t = 0; t < NT; ++t) {
#pragma unroll
        for (int j = 0; j < 4; ++j) { const float p = __expf(sc[t][j] - mx); sc[t][j] = p; sum += p; } }
    sum += __shfl_xor(sum, 16); sum += __shfl_xor(sum, 32);
    const float inv = 1.f / sum;
    f32x4 o[4];
#pragma unroll
    for (int dt = 0; dt < 4; ++dt) o[dt] = (f32x4){0.f, 0.f, 0.f, 0.f};
#pragma unroll
    for (int t2 = 0; t2 < NT / 2; ++t2) {
        union { u32x4 u; bf16x8 v; } pf; pf.u.x = pk2(sc[2 * t2][0], sc[2 * t2][1]); pf.u.y = pk2(sc[2 * t2][2], sc[2 * t2][3]); pf.u.z = pk2(sc[2 * t2 + 1][0], sc[2 * t2 + 1][1]); pf.u.w = pk2(sc[2 * t2 + 1][2], sc[2 * t2 + 1][3]);
#pragma unroll
        for (int dt = 0; dt < 4; ++dt) o[dt] = mfma16((t2 & 1) ? vfb[dt] : vfa[dt], pf.v, o[dt]);
        if (t2 + 2 < NT / 2) { if (t2 & 1) attn_loadv<WIN>(vfb, VT, CV, t2 + 2, b, h, rs, kb, ctok0, li, g); else attn_loadv<WIN>(vfa, VT, CV, t2 + 2, b, h, rs, kb, ctok0, li, g); }
        __builtin_amdgcn_sched_barrier(0);
    }
#pragma unroll
    for (int dt = 0; dt < 4; ++dt) { u32x2 w; w.x = pk2(o[dt][0] * inv, o[dt][1] * inv); w.y = pk2(o[dt][2] * inv, o[dt][3] * inv);
        *(u32x2*)(CAT + (unsigned)((qtok0 + li) * 1024 + h * 64 + 16 * dt + 4 * g)) = w; }
}
__device__ __forceinline__ void phase_attn(const KArgs& a, LAS unsigned char* lds, int e) {
    const int tid = TIDX(), wave = __builtin_amdgcn_readfirstlane(tid >> 6), lane = tid & 63;
    const bf16* QK = (const bf16*)(WSB(a) + WS_BIG + EV_QK); const bf16* VT = (const bf16*)(WSB(a) + WS_BIG + EV_UT); bf16* CAT = (bf16*)(WSB(a) + WS_BIG + EV_CAT);
    LAS float* rpbL = (LAS float*)lds; LAS bf16* CKs = (LAS bf16*)(lds + 2048); LAS bf16* CVs = (LAS bf16*)(lds + 2048 + 36864);
    for (int bt = BIDX(); bt < 2048 + 128; bt += gridDim.x) {
        if (bt < 2048) { const int bs = ((bt & 7) << 8) + (bt >> 3); const int b = bs >> 8, h = (bs >> 5) & 7, rp = bs & 31; const int r = 2 * rp + (wave >> 2), c0 = 16 * (wave & 3);
            __syncthreads();
            if (tid < 465) rpbL[tid] = a.in[15][((size_t)e * 8 + h) * 465 + tid];
            { const int ctok0 = NLAT + b * CTXL;
              int tl = tid; asm volatile("" : "+v"(tl));
#pragma unroll
              for (int i = 0; i < 4; ++i) { const int pid = tl + 512 * i; *(LAS u32x4*)(CKs + (pid >> 3) * 72 + 8 * (pid & 7)) = *(const u32x4*)(QK + (unsigned)((ctok0 + (pid >> 3)) * 1024 + 512 + h * 64 + 8 * (pid & 7))); }
#pragma unroll
              for (int i = 0; i < 4; ++i) { const int pid = tl + 512 * i; *(LAS u32x4*)(CVs + (pid >> 5) * 264 + 8 * (pid & 31)) = *(const u32x4*)(VT + (unsigned)((h * 64 + (pid >> 5)) * NTOK + ctok0 + 8 * (pid & 31))); } }
            __syncthreads();
            attn_wave<true>(QK, VT, CAT, rpbL, CKs, CVs, b, h, r, c0, b * SEQ + r * 64 + c0, lane); }
        else { const int wt = (bt - 2048) * 8 + wave; const int b = wt >> 7, h = (wt >> 4) & 7, qt = wt & 15;
            attn_wave<false>(QK, VT, CAT, rpbL, CKs, CVs, b, h, 0, 0, NLAT + b * CTXL + 16 * qt, lane); }
    }
    __syncthreads();
}

__device__ __forceinline__ float sconv(const bf16* row, int tok, int t, int L, float w0, float w1, float w2, float bias) {
    const float um = t > 0 ? bf2f(row[tok - 1]) : 0.f, u0 = bf2f(row[tok]), up = t < L - 1 ? bf2f(row[tok + 1]) : 0.f;
    return um * w0 + u0 * w1 + up * w2 + bias;
}
template <int L> __device__ __forceinline__ void hyena_task(const KArgs& a, LAS unsigned char* lds, int e, int c) {
    constexpr int ZP = SEQ + 64, P = 2 * L + 16, NT = L / 32, TPW = NT / 8;
    const int tid = TIDX(), wave = tid >> 6, lane = tid & 63, li = lane & 15, g = lane >> 4;
    LAS bf16* ZT = (LAS bf16*)lds; LAS bf16* GI = (LAS bf16*)(lds + 8 * ZP * 2);
    const bf16* UT = (const bf16*)(WSB(a) + WS_BIG + EV_UT); bf16* BT = (bf16*)(WSB(a) + WS_BIG + EV_BT);
    const float* cw = a.in[16] + (size_t)e * 3 * 1536; const float* cb = a.in[17] + e * 1536;
    const int tokbase = L == SEQ ? 0 : NLAT;
    {
        const float a0 = cw[512 + c], a1 = cw[1536 + 512 + c], a2 = cw[3072 + 512 + c], ab = cb[512 + c];
        const float v0 = cw[1024 + c], v1 = cw[1536 + 1024 + c], v2 = cw[3072 + 1024 + c], vb = cb[1024 + c];
        const bf16* r1 = UT + (size_t)(1024 + c) * NTOK; const bf16* rv = UT + (size_t)(1536 + c) * NTOK;
#pragma unroll 4
        for (int idx = tid; idx < L; idx += 512) { const int b = idx / (L / 8), t0 = 8 * (idx % (L / 8)); const int tok = tokbase + b * L + t0;
            const u32x4 xa = *(const u32x4*)(r1 + tok), xv = *(const u32x4*)(rv + tok);
            const float al = t0 > 0 ? bf2f(r1[tok - 1]) : 0.f, ar = t0 + 8 < L ? bf2f(r1[tok + 8]) : 0.f, vl = t0 > 0 ? bf2f(rv[tok - 1]) : 0.f, vr = t0 + 8 < L ? bf2f(rv[tok + 8]) : 0.f;
            float xs[10], vs[10]; xs[0] = al; xs[9] = ar; vs[0] = vl; vs[9] = vr;
#pragma unroll
            for (int j = 0; j < 4; ++j) { xs[1 + 2 * j] = bflo(xa[j]); xs[2 + 2 * j] = bfhi(xa[j]); vs[1 + 2 * j] = bflo(xv[j]); vs[2 + 2 * j] = bfhi(xv[j]); }
            float z[8];
#pragma unroll
            for (int j = 0; j < 8; ++j) z[j] = (vs[j] * v0 + vs[j + 1] * v1 + vs[j + 2] * v2 + vb) * (xs[j] * a0 + xs[j + 1] * a1 + xs[j + 2] * a2 + ab);
            u32x4 w; w.x = pk2(z[0], z[1]); w.y = pk2(z[2], z[3]); w.z = pk2(z[4], z[5]); w.w = pk2(z[6], z[7]);
            *(LAS u32x4*)(ZT + b * ZP + 32 + t0) = w; }
        for (int idx = tid; idx < 8 * 32; idx += 512) { const int b = idx >> 5, p = idx & 31; ZT[b * ZP + p] = 0; ZT[b * ZP + 32 + L + p] = 0; }
        const u32x4* gs = (const u32x4*)((const bf16*)(WSB(a) + (L == SEQ ? WS_GIL : WS_GIC)) + (size_t)c * P); LAS u32x4* gd = (LAS u32x4*)GI;
        for (int idx = tid; idx < P / 8; idx += 512) gd[idx] = gs[idx];
    }
    __syncthreads();
    f32x4 acc[TPW];
#pragma unroll
    for (int q = 0; q < TPW; ++q) acc[q] = (f32x4){0.f, 0.f, 0.f, 0.f};
    const int bb = li & 7, tt = li >> 3;
    if constexpr (TPW == 16) {
        const int T0 = wave * 16;
        bf16x8 W[16];
#pragma unroll
        for (int j = 0; j < 16; ++j) W[j] = (bf16x8){0, 0, 0, 0, 0, 0, 0, 0};
        const LAS bf16* zb = ZT + bb * ZP + 32 + 16 * tt + 8 * g;
        const LAS bf16* gb = GI + (L + 15 - li + 8 * g - 32 * (T0 + 16));
        for (int blk = 0; blk < 9; ++blk) {
#pragma unroll
            for (int s16 = 0; s16 < 16; ++s16) {
                const int sg = blk * 16 + s16;
                W[(s16 + 15) & 15] = sg <= 128 ? *(const LAS bf16x8*)(zb + 32 * (sg - 1)) : (bf16x8){0, 0, 0, 0, 0, 0, 0, 0};
                union { unsigned short s[8]; bf16x8 v; } af; const LAS bf16* gp = gb + 32 * sg;
#pragma unroll
                for (int j = 0; j < 8; ++j) af.s[j] = gp[j];
#pragma unroll
                for (int q = 0; q < 16; ++q) acc[q] = mfma16(af.v, W[(q + s16) & 15], acc[q]);
            }
        }
    } else {
    for (int dq = 0; dq < 2 * L / 32; ++dq) {
        const int dl = -L + 32 * dq;
        const int T0 = wave * TPW;
        if (dl < -32 * (T0 + TPW - 1) - 32 || dl > L - 32 - 32 * T0) continue;
        union { unsigned short s[8]; bf16x8 v; } af; const LAS bf16* gp = GI + (L + 15 - li + dl + 8 * g);
#pragma unroll
        for (int j = 0; j < 8; ++j) af.s[j] = gp[j];
#pragma unroll
        for (int q = 0; q < TPW; ++q) { const int T = T0 + q;
            if (dl >= -32 * T - 32 && dl <= L - 32 - 32 * T) { const bf16x8 bv = *(const LAS bf16x8*)(ZT + bb * ZP + 32 + 32 * T + 16 * tt + dl + 8 * g); acc[q] = mfma16(af.v, bv, acc[q]); } }
    }
    }
    {
        const float a0 = cw[c], a1 = cw[1536 + c], a2 = cw[3072 + c], ab = cb[c]; const float dbias = a.in[26][e * 512 + c];
        const bf16* r0 = UT + (size_t)(512 + c) * NTOK;
#pragma unroll
        for (int q = 0; q < TPW; ++q) { const int T = wave * TPW + q; const int t0 = 32 * T + 16 * tt + 4 * g; const int tok = tokbase + bb * L + t0;
            const u32x2 xx = *(const u32x2*)(r0 + tok); const u32x2 zz = *(const LAS u32x2*)(ZT + bb * ZP + 32 + t0);
            float xs[6]; xs[0] = t0 > 0 ? bf2f(r0[tok - 1]) : 0.f; xs[5] = t0 + 4 < L ? bf2f(r0[tok + 4]) : 0.f; xs[1] = bflo(xx.x); xs[2] = bfhi(xx.x); xs[3] = bflo(xx.y); xs[4] = bfhi(xx.y);
            const float zf[4] = {bflo(zz.x), bfhi(zz.x), bflo(zz.y), bfhi(zz.y)};
            float o[4];
#pragma unroll
            for (int j = 0; j < 4; ++j) o[j] = (acc[q][j] + zf[j] * dbias) * (xs[j] * a0 + xs[j + 1] * a1 + xs[j + 2] * a2 + ab);
            u32x2 w; w.x = pk2(o[0], o[1]); w.y = pk2(o[2], o[3]); *(u32x2*)(BT + (size_t)c * NTOK + tok) = w; }
    }
    __syncthreads();
}
__device__ __forceinline__ void phase_hyena(const KArgs& a, LAS unsigned char* lds, int e) {
    for (int task = BIDX(); task < 1024; task += gridDim.x) { if (task < 512) hyena_task<SEQ>(a, lds, e, task); else hyena_task<CTXL>(a, lds, e, task - 512); }
}
__device__ __forceinline__ void phase_bt_transpose(const KArgs& a, LAS unsigned char* lds) {
    const int wave = TIDX() >> 6, lane = TIDX() & 63; const int gw = BIDX() * 8 + wave, NGW = gridDim.x * 8;
    LAS bf16* scr = (LAS bf16*)(lds + wave * 16384);
    const bf16* BT = (const bf16*)(WSB(a) + WS_BIG + EV_BT); bf16* CAT = (bf16*)(WSB(a) + WS_BIG + EV_CAT);
    for (int tile = gw; tile < 8 * (NTOK / 64); tile += NGW) { const int cb = tile & 7, tb = tile >> 3;
#pragma unroll 4
        for (int i = 0; i < 64; ++i) scr[i * 66 + lane] = BT[(size_t)(cb * 64 + i) * NTOK + tb * 64 + lane];
        asm volatile("s_waitcnt lgkmcnt(0)" ::: "memory");
#pragma unroll 4
        for (int j = 0; j < 64; ++j) CAT[(size_t)(tb * 64 + j) * 1024 + 512 + cb * 64 + lane] = scr[lane * 66 + j];
        asm volatile("s_waitcnt lgkmcnt(0)" ::: "memory");
    }
}
typedef short s16x4 __attribute__((ext_vector_type(4)));
__device__ __forceinline__ s16x4 tr16(const LAS bf16* p) { return __builtin_amdgcn_ds_read_tr16_b64_v4i16((LAS s16x4*)p); }
__device__ __forceinline__ int ret_tok0(int n, int dir, int b) { return n < 2 ? NLAT + b * CTXL + 128 * (dir ? 1 - n : n) : b * SEQ + 128 * (dir ? 33 - n : n - 2); }
__device__ __forceinline__ void phase_retscan(const KArgs& a, LAS unsigned char* lds, int o) {
    const int tid = TIDX(), wave = __builtin_amdgcn_readfirstlane(tid >> 6), lane = tid & 63, li = lane & 15, g = lane >> 4;
    constexpr int KP = 264, VP = 72, SP = 264;
    LAS bf16* KL = (LAS bf16*)lds; LAS bf16* VL = (LAS bf16*)(lds + 67584); LAS bf16* ST = (LAS bf16*)(lds + 67584 + 18432);
    const bf16* QKV = (const bf16*)(WSB(a) + WS_BIG + RT_QK); bf16* O = (bf16*)(WSB(a) + WS_BIG + RT_O);
    for (int task = BIDX(); task < 256; task += gridDim.x) {
        const int p = (task & 7) * 4 + (task >> 6), es = (task >> 3) & 7; const int b = p >> 2, hd = p & 3;
        for (int dir = 0; dir < 2; ++dir) {
            int tidd = tid; asm volatile("" : "+v"(tidd));
            const float logit = (dir ? a.in[30] : a.in[29])[o * 4 + hd];
            const float lg = fminf(logit, 0.f) - log1pf(expf(-fabsf(logit)));
            const float gch = expf(lg * 128.f);
            f32x4 st[2][4];
#pragma unroll
            for (int mt = 0; mt < 2; ++mt)
#pragma unroll
                for (int nt = 0; nt < 4; ++nt) st[mt][nt] = (f32x4){0.f, 0.f, 0.f, 0.f};
            for (int i = tidd; i < 64 * SP / 2; i += 512) ((LAS unsigned*)ST)[i] = 0u;
            const int lid = tidd & 15, gd = (tidd & 63) >> 4; const int qt = wave < 4 ? wave : 11 - wave;
            const int iq = 16 * qt + lid;
            const float xi = expf(lg * (dir ? (float)(128 - iq) : (float)(iq + 1)));
            const float sgl = dir ? -lg : lg;
            const float cm0 = expf(sgl * (float)(iq - 4 * gd)), rm1 = expf(-sgl);
            const float hz0 = expf(lg * (dir ? (float)(8 * gd) : (float)(127 - 8 * gd))), rz1 = expf(dir ? lg : -lg);
            const float r16 = expf(-sgl * 16.f), r32 = expf(-sgl * 32.f);
            bf16x8 qf[8];
            {
                const int tok0 = ret_tok0(0, dir, b);
#pragma unroll
                for (int i = 0; i < 8; ++i) { const int pid = tidd + 512 * i, row = pid >> 5, c16 = pid & 31; *(LAS u32x4*)(KL + row * KP + 8 * c16) = *(const u32x4*)(QKV + (unsigned)((tok0 + row) * 4096 + 1024 + hd * 256 + 8 * c16)); }
#pragma unroll
                for (int i = 0; i < 2; ++i) { const int pid = tidd + 512 * i, row = pid >> 3, c16 = pid & 7; *(LAS u32x4*)(VL + row * VP + 8 * c16) = *(const u32x4*)(QKV + (unsigned)((tok0 + row) * 4096 + 2048 + hd * 512 + es * 64 + 8 * c16)); }
                const bf16* qp = QKV + (unsigned)((tok0 + iq) * 4096 + hd * 256 + 8 * gd);
#pragma unroll
                for (int ks = 0; ks < 8; ++ks) qf[ks] = *(const bf16x8*)(qp + 32 * ks);
            }
            __syncthreads();
            for (int n = 0; n < 34; ++n) {
                float lgc = lg; asm volatile("" : "+v"(lgc)); int lic = li; asm volatile("" : "+v"(lic)); int gc = g; asm volatile("" : "+v"(gc)); int tidc = tid; asm volatile("" : "+v"(tidc)); int wvc = wave; asm volatile("" : "+s"(wvc)); float cm0c = cm0; asm volatile("" : "+v"(cm0c)); float hz0c = hz0; asm volatile("" : "+v"(hz0c));
                int qtc = qt; asm volatile("" : "+s"(qtc)); const int iqc = 16 * qtc + lic;
                const int tok0 = ret_tok0(n, dir, b);
                const bool more = n + 1 < 34; const int tokn = more ? ret_tok0(n + 1, dir, b) : tok0;
                u32x4 kreg[8], vreg[2]; u32x2 oldo[4] = {};
#pragma unroll
                for (int i = 0; i < 8; ++i) { const int pid = tidc + 512 * i, row = pid >> 5, c16 = pid & 31; kreg[i] = *(const u32x4*)(QKV + (unsigned)((tokn + row) * 4096 + 1024 + hd * 256 + 8 * c16)); }
#pragma unroll
                for (int i = 0; i < 2; ++i) { const int pid = tidc + 512 * i, row = pid >> 3, c16 = pid & 7; vreg[i] = *(const u32x4*)(QKV + (unsigned)((tokn + row) * 4096 + 2048 + hd * 512 + es * 64 + 8 * c16)); }
                bf16* orow = O + (unsigned)((tok0 + iqc) * 2048 + hd * 512 + es * 64 + 4 * gc);
                union { u32x4 u; bf16x8 v; } pf[4];
                float btc = 1.f;
#pragma unroll
                for (int jt = 0; jt < 8; ++jt) {
                    f32x4 acc = {0.f, 0.f, 0.f, 0.f};
                    const bool need = dir ? (jt >= qtc) : (jt <= qtc);
                    if (need) { const LAS bf16* kp = KL + (16 * jt + lic) * KP + 8 * gc;
#pragma unroll
                        for (int ks = 0; ks < 8; ++ks) acc = mfma16(*(const LAS bf16x8*)(kp + 32 * ks), qf[ks], acc);
                        { float fm = cm0c * btc;
#pragma unroll
                        for (int j = 0; j < 4; ++j) { const int kj = 16 * jt + 4 * gc + j; const int df = dir ? kj - iqc : iqc - kj; acc[j] = df >= 0 ? acc[j] * fm : 0.f; fm *= rm1; } } }
                    btc *= r16;
                    __builtin_amdgcn_sched_barrier(0);
                    if (jt & 1) { pf[jt >> 1].u.z = pk2(acc[0], acc[1]); pf[jt >> 1].u.w = pk2(acc[2], acc[3]); } else { pf[jt >> 1].u.x = pk2(acc[0], acc[1]); pf[jt >> 1].u.y = pk2(acc[2], acc[3]); }
                }
                f32x4 o1[4];
#pragma unroll
                for (int et = 0; et < 4; ++et) o1[et] = (f32x4){0.f, 0.f, 0.f, 0.f};
#pragma unroll
                for (int ks = 0; ks < 8; ++ks) {
#pragma unroll
                    for (int et = 0; et < 4; ++et) { const bf16x8 sv = *(const LAS bf16x8*)(ST + (16 * et + lic) * SP + 32 * ks + 8 * gc); o1[et] = mfma16(sv, qf[ks], o1[et]); }
                    if (ks & 1) __builtin_amdgcn_sched_barrier(0); }
#pragma unroll
                for (int et = 0; et < 4; ++et) o1[et] = o1[et] * xi;
                __builtin_amdgcn_sched_barrier(0);
                { const bf16* qp = QKV + (unsigned)((tokn + iqc) * 4096 + hd * 256 + 8 * gc);
#pragma unroll
                  for (int ks = 0; ks < 8; ++ks) qf[ks] = *(const bf16x8*)(qp + 32 * ks); }
                if (dir) {
#pragma unroll
                    for (int et = 0; et < 4; ++et) oldo[et] = *(const u32x2*)(orow + 16 * et); }
                { const LAS bf16* vb = VL + (4 * gc + (lic >> 2)) * VP + 4 * (lic & 3);
#pragma unroll
                  for (int t2 = 0; t2 < 4; ++t2) {
#pragma unroll
                    for (int et = 0; et < 4; ++et) { const s16x4 r0 = tr16(vb + (32 * t2) * VP + 16 * et), r1 = tr16(vb + (32 * t2 + 16) * VP + 16 * et);
                        const bf16x8 va = __builtin_shufflevector(r0, r1, 0, 1, 2, 3, 4, 5, 6, 7); o1[et] = mfma16(va, pf[t2].v, o1[et]); }
                    __builtin_amdgcn_sched_barrier(0); } }
#pragma unroll
                for (int et = 0; et < 4; ++et) {
                    float r[4];
#pragma unroll
                    for (int j = 0; j < 4; ++j) r[j] = o1[et][j];
                    if (dir) { r[0] += bflo(oldo[et].x); r[1] += bfhi(oldo[et].x); r[2] += bflo(oldo[et].y); r[3] += bfhi(oldo[et].y); }
                    u32x2 w; w.x = pk2(r[0], r[1]); w.y = pk2(r[2], r[3]); *(u32x2*)(orow + 16 * et) = w; }
#pragma unroll
                for (int mt = 0; mt < 2; ++mt)
#pragma unroll
                    for (int nt = 0; nt < 4; ++nt) st[mt][nt] = st[mt][nt] * gch;
                float fks = 1.f;
                { const LAS bf16* kb = KL + (8 * gc + (lic >> 2)) * KP + 32 * wave + 4 * (lic & 3); const LAS bf16* vb = VL + (8 * gc + (lic >> 2)) * VP + 4 * (lic & 3);
#pragma unroll
                  for (int ks = 0; ks < 4; ++ks) {
                    float z[8];
                    { float zc = hz0c * fks;
#pragma unroll
                    for (int jj = 0; jj < 8; ++jj) { z[jj] = zc; zc *= rz1; } }
                    fks *= r32;
                    bf16x8 ka[2];
#pragma unroll
                    for (int mt = 0; mt < 2; ++mt) { const s16x4 r0 = tr16(kb + (32 * ks) * KP + 16 * mt), r1 = tr16(kb + (32 * ks + 4) * KP + 16 * mt);
                        union { u32x4 u; bf16x8 v; } kz;
                        kz.u.x = pk2(bf2f((unsigned short)r0[0]) * z[0], bf2f((unsigned short)r0[1]) * z[1]); kz.u.y = pk2(bf2f((unsigned short)r0[2]) * z[2], bf2f((unsigned short)r0[3]) * z[3]);
                        kz.u.z = pk2(bf2f((unsigned short)r1[0]) * z[4], bf2f((unsigned short)r1[1]) * z[5]); kz.u.w = pk2(bf2f((unsigned short)r1[2]) * z[6], bf2f((unsigned short)r1[3]) * z[7]);
                        ka[mt] = kz.v; }
#pragma unroll
                    for (int nt = 0; nt < 4; ++nt) { const s16x4 r0 = tr16(vb + (32 * ks) * VP + 16 * nt), r1 = tr16(vb + (32 * ks + 4) * VP + 16 * nt);
                        const bf16x8 vv = __builtin_shufflevector(r0, r1, 0, 1, 2, 3, 4, 5, 6, 7);
#pragma unroll
                        for (int mt = 0; mt < 2; ++mt) st[mt][nt] = mfma16(ka[mt], vv, st[mt][nt]); }
                    __builtin_amdgcn_sched_barrier(0);
                  } }
                __syncthreads();
#pragma unroll
                for (int mt = 0; mt < 2; ++mt)
#pragma unroll
                    for (int nt = 0; nt < 4; ++nt) { u32x2 w; w.x = pk2(st[mt][nt][0], st[mt][nt][1]); w.y = pk2(st[mt][nt][2], st[mt][nt][3]);
                        *(LAS u32x2*)(ST + (16 * nt + lic) * SP + 32 * wave + 16 * mt + 4 * gc) = w; }
                if (more) {
#pragma unroll
                    for (int i = 0; i < 8; ++i) { const int pid = tidc + 512 * i, row = pid >> 5, c16 = pid & 31; *(LAS u32x4*)(KL + row * KP + 8 * c16) = kreg[i]; }
#pragma unroll
                    for (int i = 0; i < 2; ++i) { const int pid = tidc + 512 * i, row = pid >> 3, c16 = pid & 7; *(LAS u32x4*)(VL + row * VP + 8 * c16) = vreg[i]; }
                }
                __syncthreads();
            }
        }
    }
}
__device__ __forceinline__ void phase_groupnorm(const KArgs& a, int nrows = NTOK) {
    const int wave = TIDX() >> 6, lane = TIDX() & 63; const int gw = BIDX() * 8 + wave, NGW = gridDim.x * 8;
    const bf16* O = (const bf16*)(WSB(a) + WS_BIG + RT_O); float* ST = (float*)(WSB(a) + WS_BIG + BIG_STATS);
    for (int row = gw; row < nrows; row += NGW) {
        const u32x4* p = (const u32x4*)(O + (size_t)row * 2048 + 32 * lane); u32x4 v[4]; float x[32];
#pragma unroll
        for (int q = 0; q < 4; ++q) { v[q] = p[q];
#pragma unroll
            for (int j = 0; j < 4; ++j) { x[8 * q + 2 * j] = bflo(v[q][j]); x[8 * q + 2 * j + 1] = bfhi(v[q][j]); } }
        float s = 0.f;
#pragma unroll
        for (int j = 0; j < 32; ++j) s += x[j];
        s += __shfl_xor(s, 1); s += __shfl_xor(s, 2); s += __shfl_xor(s, 4); s += __shfl_xor(s, 8);
        const float mu = s * (1.f / 512.f); float q2 = 0.f;
#pragma unroll
        for (int j = 0; j < 32; ++j) { const float d = x[j] - mu; q2 += d * d; }
        q2 += __shfl_xor(q2, 1); q2 += __shfl_xor(q2, 2); q2 += __shfl_xor(q2, 4); q2 += __shfl_xor(q2, 8);
        const float rstd = rsqrtf(q2 * (1.f / 512.f) + 1e-6f);
        if ((lane & 15) == 0) { ST[(size_t)row * 8 + (lane >> 4) * 2] = mu; ST[(size_t)row * 8 + (lane >> 4) * 2 + 1] = rstd; }
    }
}
#define RLX_AGENT __ATOMIC_RELAXED, __HIP_MEMORY_SCOPE_AGENT
#define XB_TMO      128
#define XB_XCNT(j)  (256  + 64 * (j))
#define XB_XSUB(j)  (1280 + 64 * (j))
#define XB_XGEN(j)  (2304 + 64 * (j))
#define XB_TOP      3328
#define XB_TOPGEN   3392
#define XCD_BAR_WORDS 3456
#define XB_SPIN_CAP (1u << 18)

__device__ __forceinline__ unsigned xb_ld(unsigned* p)              { return __hip_atomic_load(p, __ATOMIC_RELAXED, __HIP_MEMORY_SCOPE_AGENT); }
__device__ __forceinline__ unsigned xb_add(unsigned* p, unsigned v) { return __hip_atomic_fetch_add(p, v, __ATOMIC_RELAXED, __HIP_MEMORY_SCOPE_AGENT); }
__device__ __forceinline__ unsigned xb_xcc_id() { return (unsigned)__builtin_amdgcn_s_getreg((3 << 11) | 20) & 0xFu; }
#define XB_SPIN(cond, bar) do { unsigned _sp = 0; while (cond) { __builtin_amdgcn_s_sleep(1); \
    if ((++_sp & 255u) == 0u) { if (xb_ld(&(bar)[XB_TMO])) break; if (_sp > XB_SPIN_CAP) { atomicAdd(&(bar)[XB_TMO], 1u); break; } } } } while (0)

struct XcdBarrier {
    unsigned* bar; unsigned x;
    volatile LAS unsigned* st;
};

__device__ __forceinline__ XcdBarrier xcd_barrier_post(unsigned* bar, volatile LAS unsigned* st) {
    XcdBarrier b; b.bar = bar; b.x = xb_xcc_id(); b.st = st;
    if (threadIdx.x == 0) (void)xb_add(&bar[XB_XCNT(b.x)], 1u);
    return b;
}
__device__ __forceinline__ void xcd_barrier_complete(unsigned* bar, unsigned x, unsigned& nloc, unsigned& nx) {
    const unsigned G = gridDim.x * gridDim.y * gridDim.z;
    unsigned sum, cnt, mine, sp = 0u;
    for (;;) {
        sum = 0u; cnt = 0u; mine = 0u;
#pragma unroll
        for (unsigned j = 0; j < 16; ++j) { const unsigned c = xb_ld(&bar[XB_XCNT(j)]); sum += c; cnt += (c > 0u) ? 1u : 0u; mine = (j == x) ? c : mine; }
        if (sum == G) break;
        __builtin_amdgcn_s_sleep(1);
        if ((++sp & 255u) == 0u) { if (xb_ld(&bar[XB_TMO])) break; if (sp > XB_SPIN_CAP) { atomicAdd(&bar[XB_TMO], 1u); break; } }
    }
    nloc = mine > 0u ? mine : 1u; nx = cnt > 0u ? cnt : 1u;
}

__device__ __forceinline__ void xcd_barrier(const XcdBarrier& b) {
    asm volatile("s_waitcnt vmcnt(0)" ::: "memory");
    __syncthreads();
    if (threadIdx.x == 0) {
        unsigned* bar = b.bar;
        __builtin_amdgcn_s_waitcnt(0);
        unsigned nloc = b.st[0], nx = b.st[1];
        if (nloc == 0u) { xcd_barrier_complete(bar, b.x, nloc, nx); b.st[0] = nloc; b.st[1] = nx; }
        const unsigned old = xb_add(&bar[XB_XSUB(b.x)], 1u);
        const unsigned gen = old / nloc;
        if (old + 1u == (gen + 1u) * nloc) {
            __builtin_amdgcn_fence(__ATOMIC_RELEASE, "agent");
            asm volatile("s_waitcnt vmcnt(0)" ::: "memory");
            const unsigned og = xb_add(&bar[XB_TOP], 1u);
            const unsigned tg = og / nx;
            if (og + 1u == (tg + 1u) * nx) xb_add(&bar[XB_TOPGEN], 1u);
            else XB_SPIN(xb_ld(&bar[XB_TOPGEN]) == tg, bar);
            __builtin_amdgcn_fence(__ATOMIC_ACQUIRE, "agent");
            xb_add(&bar[XB_XGEN(b.x)], 1u);
            asm volatile("s_waitcnt vmcnt(0)" ::: "memory");
        } else {
            XB_SPIN(xb_ld(&bar[XB_XGEN(b.x)]) == gen, bar);
            __builtin_amdgcn_fence(__ATOMIC_ACQUIRE, "agent");
            asm volatile("s_waitcnt vmcnt(0)" ::: "memory");
        }
    }
    __syncthreads();
}

#ifndef MK_MULTI
#define MK_MULTI 0
#endif
constexpr int NPH = 47;
#define REP_RET 1
#define REP_HY 1
#define REP_ATT 1
#define REP_GIN 1
#define REP_NM 1
#define REP_KV 1
#define REP_WF 1
#define REP_PRO 1
#define REP_GN 1
#define REP_GOUT 1
#define REP_MIN 1
template <class Epi> __device__ __forceinline__ void run_gemm(LAS unsigned char* lds, const bf16* A, const bf16* Bt, int M, int N, int K, const Epi E, int tailRows = 0, const bf16* A2 = nullptr, const bf16* Bt2 = nullptr, int M2 = 0, int N2 = 0) {
    pg8::Gemm g{A, Bt, M, N, K, A2, Bt2}; pg8::StaticOrder S; S.init(M, N, (int)gridDim.x, BIDX(), K, tailRows, M2, N2);
    pg8::gemm_phase<Epi, pg8::StaticOrder, !__is_same(Epi, EpiResid), true>(lds, g, S, E);
}
__global__ void __launch_bounds__(512, 2) fwd_kernel(KArgs a) {
    extern __shared__ __attribute__((aligned(16))) unsigned char lds_raw[];
    LAS unsigned char* lds = (LAS unsigned char*)lds_raw;
    cg::grid_group grid = cg::this_grid();
    if (threadIdx.x < 4) ((LAS unsigned*)(lds + LDS_BYTES - 16))[threadIdx.x] = 0u;
    __syncthreads();
    XcdBarrier xbar = xcd_barrier_post((unsigned*)(a.ws + 65536), (volatile LAS unsigned*)(lds + LDS_BYTES - 16));
    const int lo = a.ph_lo, hi = a.ph_hi < 47 ? a.ph_hi : 47;
#define WSL(off) (wsl + (off))
#define P_H ((bf16*)WSL(WS_H))
#define P_GB ((bf16*)WSL(WS_BIG + BIG_G))
#define P_XC ((float*)WSL(WS_XC))
#define P_TAB ((const float*)WSL(WS_TAB))
#define P_W(o) ((const bf16*)WSL(WS_W + (o)))
#define P_MODL ((const float*)WSL(WS_MOD) + (size_t)layer * 9 * NMODV)
    for (int ph = lo; ph < hi; ++ph) {
        size_t zoff = 0; asm volatile("" : "+s"(zoff)); unsigned char* wsl = a.ws + zoff;
        int layer = 0, step = -1;
        if (ph > 0) { const int q = ph - 1; if (q < 11) { layer = 0; step = q; } else if (q < 23) { layer = 1; step = q - 11; } else if (q < 34) { layer = 2; step = q - 23; } else { layer = 3; step = q - 34; } }
        const bool even = (layer & 1) == 0; const int e = layer >> 1;
        const int tail = even ? step - 8 : step - 9;
        if (step < 0) { for (int rr = 0; rr < REP_PRO; ++rr) phase_prologue(a, lds); }
        else if (step == 0) { for (int rr = 0; rr < REP_WF; ++rr) { phase_weights(a, lds, layer); if (even) phase_filter(a, e); } phase_normmod(a, layer, 0, NTOK, layer > 0); }
        else if (step == 3 || tail == 0) { for (int rr = 0; rr < REP_NM; ++rr) phase_normmod(a, layer, step == 3 ? 1 : 2, (layer == 3 && step != 3) ? NLAT : NTOK); }
        else if (step == 1 || tail == 1) { for (int rr = 0; rr < REP_GIN; ++rr) run_gemm(lds, P_H, P_W(step == 1 ? W_AIN : W_BIN), (layer == 3 && step > 1) ? NLAT : NTOK, 2 * DFF, DM, EpiSwiGLU{P_GB}); }
        else if (step == 2 || tail == 2 || (even && step == 7) || (!even && step == 8)) {
            const bool ffn = (step == 2 || tail == 2);
            const bf16* A = ffn ? P_GB : (const bf16*)WSL(WS_BIG + (even ? EV_CAT : RT_O)); const bf16* Bt = ffn ? P_W(step == 2 ? W_AOUT : W_BOUT) : P_W(W_MOUT);
            const int K = ffn ? DFF : (even ? DM : 2048); const int kmod = step == 2 ? 2 : (ffn ? 8 : 5);
            const bool noctx = (layer == 3) && step >= 8;
            run_gemm(lds, A, Bt, NLAT, DM, K, EpiResid{a.out, wsl, (layer == 0 && step == 2) ? a.in[0] : (const float*)a.out, layer * 9 * NMODV + kmod * DM, ffn ? 0.5f : 1.0f}, noctx ? 0 : NCTX);
        }
        else if (even && step == 4) {
            for (int rr = 0; rr < REP_MIN; ++rr) run_gemm(lds, P_H, P_W(W_MIN), NTOK, 1024, DM, EpiBf16{(bf16*)WSL(WS_BIG + EV_QK), (size_t)1024, (bf16*)WSL(WS_BIG + EV_UT), (size_t)NTOK}, 0, P_W(W_MIN) + (size_t)1024 * DM, P_H, 2048, NTOK);
        }
        else if (even && step == 5) { for (int rr = 0; rr < REP_HY; ++rr) phase_hyena(a, lds, e); phase_qknorm(a, e); }
        else if (even && step == 6) { for (int rr = 0; rr < REP_ATT; ++rr) phase_attn(a, lds, e); phase_bt_transpose(a, lds); }
        else if (!even && step == 4) for (int rr = 0; rr < REP_MIN; ++rr) run_gemm(lds, P_H, P_W(W_MIN), NTOK, 4096, DM, EpiRopeN{(bf16*)WSL(WS_BIG + RT_QK), P_TAB});
        else if (!even && step == 5) { for (int rr = 0; rr < REP_RET; ++rr) phase_retscan(a, lds, e); }
        else if (!even && step == 6) phase_groupnorm(a, layer == 3 ? NLAT : NTOK);
        else if (!even && step == 7) run_gemm(lds, P_H, P_W(W_MIN) + (size_t)4096 * DM, layer == 3 ? NLAT : NTOK, 2048, DM, EpiGate{(bf16*)WSL(WS_BIG + RT_O), (const float*)WSL(WS_BIG + BIG_STATS)});
        if (ph + 1 < hi) { if (ph == 0) grid.sync(); else xcd_barrier(xbar); }
    }
}

extern "C" void kernel_launch(void* const* d_in, const int* in_sizes, int n_in, void* d_out, int out_size, void* d_ws, size_t ws_size, hipStream_t stream) {
    static int grid = 0;
    if (grid == 0) {
        if (n_in != 31 || out_size != NLAT * DM || ws_size < WS_NEED) { fprintf(stderr, "kernel_launch: unexpected shapes / workspace (n_in %d out %d ws %zu need %zu)\n", n_in, out_size, ws_size, (size_t)WS_NEED); grid = -1; return; }
        int dev = 0, cus = 0, per_cu = 0;
        (void)hipGetDevice(&dev); (void)hipDeviceGetAttribute(&cus, hipDeviceAttributeMultiprocessorCount, dev);
        if (hipFuncSetAttribute((const void*)fwd_kernel, hipFuncAttributeMaxDynamicSharedMemorySize, LDS_BYTES) != hipSuccess) { fprintf(stderr, "kernel_launch: hipFuncSetAttribute failed\n"); grid = -1; return; }
        if (hipOccupancyMaxActiveBlocksPerMultiprocessor(&per_cu, (const void*)fwd_kernel, 512, LDS_BYTES) != hipSuccess || per_cu < 1) { fprintf(stderr, "kernel_launch: occupancy query says %d\n", per_cu); per_cu = 1; }
        (void)hipGetLastError();
        grid = cus * per_cu;
    }
    if (grid < 0) return;
    (void)hipMemsetAsync((unsigned char*)d_ws + 65536, 0, 16384, stream);
    KArgs a{};
    for (int i = 0; i < 31; ++i) a.in[i] = (const float*)d_in[i];
    a.out = (float*)d_out; a.ws = (unsigned char*)d_ws;
#if MK_MULTI
    for (int p = 0; p < NPH; ++p) { a.ph_lo = p; a.ph_hi = p + 1; hipLaunchKernelGGL(fwd_kernel, dim3(grid), dim3(512), LDS_BYTES, stream, a); }
#else
    a.ph_lo = 0; a.ph_hi = NPH;
    void* args[] = {&a};
    hipError_t e = hipLaunchCooperativeKernel((const void*)fwd_kernel, dim3(grid), dim3(512), args, LDS_BYTES, stream);
    if (e != hipSuccess) fprintf(stderr, "cooperative launch failed: %s (grid %d)\n", hipGetErrorString(e), grid);
#endif
}
```
